# Optimizing an MI355X kernel written in HIP

```python
import math
import jax, jax.numpy as jnp
from jax import lax
import numpy as np

D_MODEL = 1024
BATCH = 8
SEQ = 4096
DEPTH = 2

GRID_W = 64
ATTN_Q_HEADS = 8
ATTN_KV_HEADS = 2
ATTN_HEAD_DIM = 64
ATTN_WIDTH = ATTN_Q_HEADS * ATTN_HEAD_DIM
ATTN_KV_WIDTH = ATTN_KV_HEADS * ATTN_HEAD_DIM
Q_BLOCK = 128
RET_HEADS = 4
RET_HEAD_DIM = 128
RET_WIDTH = RET_HEADS * RET_HEAD_DIM
RET_CHUNK = 128
N_BRANCHES = 2
ROPE_THETA = 10000.0
EPS = 1e-6
IN_SPLITS = (ATTN_WIDTH, ATTN_KV_WIDTH, ATTN_KV_WIDTH, ATTN_WIDTH,
             RET_WIDTH, RET_WIDTH, RET_WIDTH, RET_WIDTH, N_BRANCHES * D_MODEL)
D_IN = sum(IN_SPLITS)

kernel_name = "hybrid_gqa_retention_gated_encoder"


def rms_norm(x, g):
    xf = x.astype(jnp.float32)
    y = xf * lax.rsqrt(jnp.mean(xf * xf, axis=-1, keepdims=True) + EPS)
    return (y * g.astype(jnp.float32)).astype(x.dtype)


def head_group_norm(o, w):
    mu = jnp.mean(o, axis=-1, keepdims=True)
    var = jnp.mean(jnp.square(o - mu), axis=-1, keepdims=True)
    y = (o - mu) * lax.rsqrt(var + EPS)
    b, s, h, d = o.shape
    return y.reshape(b, s, h * d) * w.astype(jnp.float32)


def axial_rope_tables(seq_len, head_dim):
    n_rows = seq_len // GRID_W
    row = jnp.repeat(jnp.arange(n_rows, dtype=jnp.float32), GRID_W)
    col = jnp.tile(jnp.arange(GRID_W, dtype=jnp.float32), n_rows)
    d_axis = head_dim // 2
    inv_freq = ROPE_THETA ** (-jnp.arange(0, d_axis, 2, dtype=jnp.float32) / d_axis)
    ang = jnp.concatenate([row[:, None] * inv_freq, col[:, None] * inv_freq], axis=-1)
    return jnp.cos(ang), jnp.sin(ang)


def apply_axial_rope(x, cos, sin):
    b, s, h, hd = x.shape
    q = hd // 4
    xf = x.astype(jnp.float32).reshape(b, s, h, 2, 2, q)
    x1 = xf[..., 0, :]
    x2 = xf[..., 1, :]
    c = cos.reshape(s, 1, 2, q)
    sn = sin.reshape(s, 1, 2, q)
    out = jnp.stack([x1 * c - x2 * sn, x1 * sn + x2 * c], axis=-2)
    return out.reshape(b, s, h, hd).astype(x.dtype)


def block_attention(q, k, v):
    b, s, hq, hd = q.shape
    hkv = k.shape[2]
    g = hq // hkv
    nb = s // Q_BLOCK
    qb = q.reshape(b, nb, Q_BLOCK, hkv, g, hd).transpose(1, 0, 2, 3, 4, 5)
    scale = hd ** -0.5

    def one_block(q_blk):
        sc = jnp.einsum('bqkgd,bskd->bkgqs', q_blk, k,
                        preferred_element_type=jnp.float32) * scale
        p = jax.nn.softmax(sc, axis=-1).astype(v.dtype)
        return jnp.einsum('bkgqs,bskd->bqkgd', p, v)

    o = lax.map(one_block, qb)
    return o.transpose(1, 0, 2, 3, 4, 5).reshape(b, s, hq * hd)


def retention_scan(q, k, v, log_gamma, strict):
    b, s, h, dk = q.shape
    dv = v.shape[-1]
    c = RET_CHUNK
    nc = s // c

    def to_chunks(t):
        return t.reshape(b, nc, c, h, t.shape[-1]).transpose(1, 0, 3, 2, 4)

    lg = log_gamma.astype(jnp.float32)[:, None]
    idx = jnp.arange(c, dtype=jnp.float32)
    diff = idx[:, None] - idx[None, :]
    mask = (diff > 0) if strict else (diff >= 0)
    dmat = jnp.where(mask[None], jnp.exp(jnp.maximum(diff, 0.0)[None] * lg[:, :, None]), 0.0)
    q_decay = jnp.exp((idx + 1.0)[None] * lg)
    k_decay = jnp.exp((c - 1.0 - idx)[None] * lg)
    chunk_decay = jnp.exp(c * lg[:, 0])

    def step(state, inp):
        qi, ki, vi = inp
        qf = qi.astype(jnp.float32)
        kf = ki.astype(jnp.float32)
        vf = vi.astype(jnp.float32)
        intra = jnp.einsum('bhij,bhje->bhie', jnp.einsum('bhid,bhjd->bhij', qf, kf) * dmat, vf)
        cross = jnp.einsum('bhid,bhde->bhie', qf, state) * q_decay[..., None]
        state = state * chunk_decay[:, None, None] + jnp.einsum(
            'bhjd,bhje->bhde', kf * k_decay[..., None], vf)
        return state, intra + cross

    state0 = jnp.zeros((b, h, dk, dv), jnp.float32)
    _, o = lax.scan(step, state0, (to_chunks(q), to_chunks(k), to_chunks(v)))
    return o.transpose(1, 0, 3, 2, 4).reshape(b, s, h, dv)


def bidirectional_retention(q, k, v, log_gamma_fwd, log_gamma_bwd):
    fwd = retention_scan(q, k, v, log_gamma_fwd, strict=False)
    flip = lambda t: jnp.flip(t, axis=1)
    bwd = flip(retention_scan(flip(q), flip(k), flip(v), log_gamma_bwd, strict=True))
    return fwd + bwd


def split_columns(z):
    offs = []
    acc = 0
    for w in IN_SPLITS[:-1]:
        acc += w
        offs.append(acc)
    return jnp.split(z, offs, axis=-1)


def setup_inputs(seed: int = 0) -> dict:
    key = jax.random.key(seed)
    ks = jax.random.split(key, 14)
    f32 = jnp.float32
    x = jax.random.normal(ks[0], (BATCH, SEQ, D_MODEL), f32)
    norm_g = 1.0 + 0.02 * jax.random.normal(ks[1], (DEPTH, D_MODEL), f32)
    w_in = jax.random.normal(ks[2], (DEPTH, D_MODEL, D_IN), f32) * D_MODEL ** -0.5
    attn_q_norm = 1.0 + 0.02 * jax.random.normal(ks[3], (DEPTH, ATTN_HEAD_DIM), f32)
    attn_k_norm = 1.0 + 0.02 * jax.random.normal(ks[4], (DEPTH, ATTN_HEAD_DIM), f32)
    base_logit = jnp.log(2.0 ** (5.0 + jnp.arange(RET_HEADS, dtype=f32)) - 1.0)
    ret_decay_fwd = base_logit[None] + 0.1 * jax.random.normal(ks[5], (DEPTH, RET_HEADS), f32)
    ret_decay_bwd = base_logit[None] + 0.1 * jax.random.normal(ks[6], (DEPTH, RET_HEADS), f32)
    ret_gn_w = 1.0 + 0.02 * jax.random.normal(ks[7], (DEPTH, RET_WIDTH), f32)
    w_branch_attn = jax.random.normal(ks[8], (DEPTH, ATTN_WIDTH, D_MODEL), f32) * ATTN_WIDTH ** -0.5
    w_branch_ret = jax.random.normal(ks[9], (DEPTH, RET_WIDTH, D_MODEL), f32) * RET_WIDTH ** -0.5
    w_out = jax.random.normal(ks[10], (DEPTH, D_MODEL, D_MODEL), f32) * D_MODEL ** -0.5
    final_norm_g = 1.0 + 0.02 * jax.random.normal(ks[11], (D_MODEL,), f32)
    return {"x": x, "norm_g": norm_g, "w_in": w_in, "attn_q_norm": attn_q_norm,
            "attn_k_norm": attn_k_norm, "ret_decay_fwd": ret_decay_fwd,
            "ret_decay_bwd": ret_decay_bwd, "ret_gn_w": ret_gn_w,
            "w_branch_attn": w_branch_attn, "w_branch_ret": w_branch_ret,
            "w_out": w_out, "final_norm_g": final_norm_g}


def reference(x, norm_g, w_in, attn_q_norm, attn_k_norm, ret_decay_fwd, ret_decay_bwd,
              ret_gn_w, w_branch_attn, w_branch_ret, w_out, final_norm_g):
    b, s, d = x.shape
    dt = x.dtype
    cos_a, sin_a = axial_rope_tables(s, ATTN_HEAD_DIM)
    cos_r, sin_r = axial_rope_tables(s, RET_HEAD_DIM)

    for layer in range(DEPTH):
        h = rms_norm(x, norm_g[layer])
        z = h @ w_in[layer]
        qa, ka, va, ga, qr, kr, vr, gr, gm = split_columns(z)

        qa = rms_norm(qa.reshape(b, s, ATTN_Q_HEADS, ATTN_HEAD_DIM), attn_q_norm[layer])
        ka = rms_norm(ka.reshape(b, s, ATTN_KV_HEADS, ATTN_HEAD_DIM), attn_k_norm[layer])
        qa = apply_axial_rope(qa, cos_a, sin_a)
        ka = apply_axial_rope(ka, cos_a, sin_a)
        va = va.reshape(b, s, ATTN_KV_HEADS, ATTN_HEAD_DIM)
        oa = block_attention(qa, ka, va)
        ya = (jax.nn.silu(ga) * oa) @ w_branch_attn[layer]

        qr = apply_axial_rope(qr.reshape(b, s, RET_HEADS, RET_HEAD_DIM), cos_r, sin_r)
        kr = apply_axial_rope(kr.reshape(b, s, RET_HEADS, RET_HEAD_DIM), cos_r, sin_r)
        kr = kr * (RET_HEAD_DIM ** -0.5)
        vr = vr.reshape(b, s, RET_HEADS, RET_HEAD_DIM)
        lg_f = jax.nn.log_sigmoid(ret_decay_fwd[layer].astype(jnp.float32))
        lg_b = jax.nn.log_sigmoid(ret_decay_bwd[layer].astype(jnp.float32))
        orr = bidirectional_retention(qr, kr, vr, lg_f, lg_b)
        orr = head_group_norm(orr, ret_gn_w[layer]).astype(dt)
        yb = (jax.nn.silu(gr) * orr) @ w_branch_ret[layer]

        gates = jax.nn.sigmoid(gm.astype(jnp.float32)).astype(dt).reshape(b, s, N_BRANCHES, d)
        merged = gates[:, :, 0] * ya + gates[:, :, 1] * yb
        x = x + merged @ w_out[layer]

    return rms_norm(x, final_norm_g)
```

```cpp
#include <hip/hip_runtime.h>
#include <cstdio>
#include <cstdint>

constexpr int BATCH = 8, SEQ = 4096, DM = 1024, DEPTH = 2, M = BATCH * SEQ, D_IN = 5376;
typedef unsigned short bf16_t;
constexpr float C2 = 0.125f * 1.4426950408889634f;
constexpr float EPS = 1e-6f;

__device__ __forceinline__ float bf2f(unsigned v) { return __uint_as_float(v << 16); }
__device__ __forceinline__ unsigned f2bf(float f) { unsigned u = __float_as_uint(f); return (u + 0x7fffu + ((u >> 16) & 1u)) >> 16; }
__device__ __forceinline__ float wave_sum(float v) {
#pragma unroll
    for (int o = 1; o < 64; o <<= 1) v += __shfl_xor(v, o);
    return v;
}
__device__ __forceinline__ float silu_f(float v) { return v / (1.f + __expf(-v)); }
__device__ __forceinline__ float sigm_f(float v) { return 1.f / (1.f + __expf(-v)); }

constexpr size_t MiB = 1u << 20;
constexpr size_t WS_ROPE = 1 * MiB;
constexpr size_t WS_XN = 32 * MiB, WS_QA = 96 * MiB, WS_KVA = 128 * MiB, WS_GA = 144 * MiB, WS_QR = 176 * MiB, WS_KR = 208 * MiB, WS_VR = 240 * MiB, WS_GR = 272 * MiB, WS_GM = 304 * MiB, WS_MG = WS_KR, WS_END = 432 * MiB;

__global__ void rope_tab_kernel(float* tab) {
    const int i = threadIdx.x + blockIdx.x * blockDim.x;
    if (i < 1024) { const int p = i / 16, f = i % 16; const float inv = powf(10000.f, -(float)f / 16.f); const float a = (float)p * inv; tab[i] = cosf(a); tab[1024 + i] = sinf(a); }
    if (i < 2048) { const int p = i / 32, f = i % 32; const float inv = powf(10000.f, -(float)f / 32.f); const float a = (float)p * inv; tab[2048 + i] = cosf(a); tab[4096 + i] = sinf(a); }
}

__global__ void __launch_bounds__(256) norm_kernel(const float* __restrict__ x, const float* __restrict__ g, bf16_t* __restrict__ xn) {
    const int row = blockIdx.x * 4 + (threadIdx.x >> 6), lane = threadIdx.x & 63;
    const float4* xr = (const float4*)(x + (size_t)row * DM) + lane;
    float4 v[4]; float s = 0.f;
#pragma unroll
    for (int j = 0; j < 4; ++j) { v[j] = xr[64 * j]; s += v[j].x * v[j].x + v[j].y * v[j].y + v[j].z * v[j].z + v[j].w * v[j].w; }
    s = wave_sum(s);
    const float rstd = rsqrtf(s * (1.f / DM) + EPS);
    const float4* gr = (const float4*)g + lane;
#pragma unroll
    for (int j = 0; j < 4; ++j) { const float4 gg = gr[64 * j];
        uint2 o; o.x = f2bf(v[j].x * rstd * gg.x) | (f2bf(v[j].y * rstd * gg.y) << 16); o.y = f2bf(v[j].z * rstd * gg.z) | (f2bf(v[j].w * rstd * gg.w) << 16);
        *(uint2*)(xn + (size_t)row * DM + 4 * lane + 256 * j) = o; }
}
__global__ void __launch_bounds__(256) final_norm_kernel(const float* x, const float* __restrict__ g, float* out) {
    const int row = blockIdx.x * 4 + (threadIdx.x >> 6), lane = threadIdx.x & 63;
    const float4* xr = (const float4*)(x + (size_t)row * DM) + lane;
    float4 v[4]; float s = 0.f;
#pragma unroll
    for (int j = 0; j < 4; ++j) { v[j] = xr[64 * j]; s += v[j].x * v[j].x + v[j].y * v[j].y + v[j].z * v[j].z + v[j].w * v[j].w; }
    s = wave_sum(s);
    const float rstd = rsqrtf(s * (1.f / DM) + EPS);
    const float4* gr = (const float4*)g + lane;
#pragma unroll
    for (int j = 0; j < 4; ++j) { const float4 gg = gr[64 * j]; float4 o; o.x = v[j].x * rstd * gg.x; o.y = v[j].y * rstd * gg.y; o.z = v[j].z * rstd * gg.z; o.w = v[j].w * rstd * gg.w;
        *((float4*)(out + (size_t)row * DM) + lane + 64 * j) = o; }
}

__device__ __forceinline__ void gemm16x64(const bf16_t* __restrict__ A, int lda, int K, const float* __restrict__ W, int ldw, int r0, int col, float (&acc)[16], float (*xs)[260]) {
    const int lane = threadIdx.x;
    for (int k0 = 0; k0 < K; k0 += 256) {
        __syncthreads();
#pragma unroll
        for (int r = 0; r < 16; ++r) { const uint2 p = *(const uint2*)(A + (size_t)(r0 + r) * lda + k0 + lane * 4);
            float4 f; f.x = bf2f(p.x & 0xffffu); f.y = bf2f(p.x >> 16); f.z = bf2f(p.y & 0xffffu); f.w = bf2f(p.y >> 16); *(float4*)&xs[r][lane * 4] = f; }
        __syncthreads();
        for (int kk = 0; kk < 256; kk += 4) {
            const float* wp = W + (size_t)(k0 + kk) * ldw + col;
            const float w0 = wp[0], w1 = wp[ldw], w2 = wp[2 * (size_t)ldw], w3 = wp[3 * (size_t)ldw];
#pragma unroll
            for (int r = 0; r < 16; ++r) { const float4 xv = *(const float4*)&xs[r][kk]; acc[r] += xv.x * w0 + xv.y * w1 + xv.z * w2 + xv.w * w3; }
        }
    }
}

__global__ void __launch_bounds__(64) inproj_naive(const bf16_t* __restrict__ XN, const float* __restrict__ W, const float* __restrict__ qn, const float* __restrict__ kn, const float* __restrict__ tab,
                                                   bf16_t* QA, bf16_t* KVA, bf16_t* GA, bf16_t* QR, bf16_t* KR, bf16_t* VR, bf16_t* GR, bf16_t* GM) {
    __shared__ float xs[16][260];
    const int g = blockIdx.x, r0 = blockIdx.y * 16, lane = threadIdx.x;
    float acc[16];
#pragma unroll
    for (int r = 0; r < 16; ++r) acc[r] = 0.f;
    gemm16x64(XN, DM, DM, W, D_IN, r0, g * 64 + lane, acc, xs);
#pragma unroll
    for (int r = 0; r < 16; ++r) {
        const float v = acc[r]; const size_t row = (size_t)(r0 + r); const int t = (r0 + r) & (SEQ - 1), prow = t >> 6, pcol = t & 63;
        if (g < 10) {
            const float ss = wave_sum(v * v); const float rstd = rsqrtf(ss * (1.f / 64.f) + EPS);
            const float y = v * rstd * (g < 8 ? qn : kn)[lane];
            const int axis = lane >> 5, half = (lane >> 4) & 1, f = lane & 15, pos = axis ? pcol : prow;
            const float c = tab[pos * 16 + f], s = tab[1024 + pos * 16 + f];
            const float pr = __shfl_xor(y, 16);
            const float o = half == 0 ? y * c - pr * s : pr * s + y * c;
            if (g < 8) QA[row * 512 + g * 64 + lane] = (bf16_t)f2bf(o * C2); else KVA[row * 256 + (g - 8) * 64 + lane] = (bf16_t)f2bf(o);
        } else if (g < 12) { KVA[row * 256 + 128 + (g - 10) * 64 + lane] = (bf16_t)f2bf(v);
        } else if (g < 20) { GA[row * 512 + (g - 12) * 64 + lane] = (bf16_t)f2bf(silu_f(v));
        } else if (g < 36) {
            const int gg = (g - 20) & 7, axis = gg & 1, half = lane >> 5, f = lane & 31, pos = axis ? pcol : prow;
            const float c = tab[2048 + pos * 32 + f], s = tab[4096 + pos * 32 + f];
            const float pr = __shfl_xor(v, 32);
            const float o = half == 0 ? v * c - pr * s : pr * s + v * c;
            if (g < 28) QR[row * 512 + gg * 64 + lane] = (bf16_t)f2bf(o); else KR[row * 512 + gg * 64 + lane] = (bf16_t)f2bf(o * 0.08838834764831845f);
        } else if (g < 44) { VR[row * 512 + (g - 36) * 64 + lane] = (bf16_t)f2bf(v);
        } else if (g < 52) { GR[row * 512 + (g - 44) * 64 + lane] = (bf16_t)f2bf(silu_f(v));
        } else { GM[row * 2048 + (g - 52) * 64 + lane] = (bf16_t)f2bf(sigm_f(v)); }
    }
}

__global__ void __launch_bounds__(64) attn_naive(bf16_t* QA, const bf16_t* __restrict__ KVA, const bf16_t* __restrict__ GA) {
    __shared__ float ks[64][64], vs[64][64];
    const int qb = blockIdx.x, h = blockIdx.y, b = blockIdx.z, lane = threadIdx.x, kvh = h >> 2;
    const size_t row = (size_t)b * SEQ + qb * 64 + lane;
    float q[64], o[64];
#pragma unroll
    for (int c = 0; c < 8; ++c) { const uint4 p = *(const uint4*)(QA + row * 512 + h * 64 + c * 8);
        q[c * 8 + 0] = bf2f(p.x & 0xffffu); q[c * 8 + 1] = bf2f(p.x >> 16); q[c * 8 + 2] = bf2f(p.y & 0xffffu); q[c * 8 + 3] = bf2f(p.y >> 16);
        q[c * 8 + 4] = bf2f(p.z & 0xffffu); q[c * 8 + 5] = bf2f(p.z >> 16); q[c * 8 + 6] = bf2f(p.w & 0xffffu); q[c * 8 + 7] = bf2f(p.w >> 16); }
#pragma unroll
    for (int d = 0; d < 64; ++d) o[d] = 0.f;
    float m = -INFINITY, l = 0.f;
    for (int kt = 0; kt < SEQ / 64; ++kt) {
        __syncthreads();
        const size_t krow = (size_t)b * SEQ + kt * 64 + lane;
#pragma unroll
        for (int c = 0; c < 8; ++c) {
            const uint4 p = *(const uint4*)(KVA + krow * 256 + kvh * 64 + c * 8);
            ks[lane][c * 8 + 0] = bf2f(p.x & 0xffffu); ks[lane][c * 8 + 1] = bf2f(p.x >> 16); ks[lane][c * 8 + 2] = bf2f(p.y & 0xffffu); ks[lane][c * 8 + 3] = bf2f(p.y >> 16);
            ks[lane][c * 8 + 4] = bf2f(p.z & 0xffffu); ks[lane][c * 8 + 5] = bf2f(p.z >> 16); ks[lane][c * 8 + 6] = bf2f(p.w & 0xffffu); ks[lane][c * 8 + 7] = bf2f(p.w >> 16);
            const uint4 u = *(const uint4*)(KVA + krow * 256 + 128 + kvh * 64 + c * 8);
            vs[lane][c * 8 + 0] = bf2f(u.x & 0xffffu); vs[lane][c * 8 + 1] = bf2f(u.x >> 16); vs[lane][c * 8 + 2] = bf2f(u.y & 0xffffu); vs[lane][c * 8 + 3] = bf2f(u.y >> 16);
            vs[lane][c * 8 + 4] = bf2f(u.z & 0xffffu); vs[lane][c * 8 + 5] = bf2f(u.z >> 16); vs[lane][c * 8 + 6] = bf2f(u.w & 0xffffu); vs[lane][c * 8 + 7] = bf2f(u.w >> 16);
        }
        __syncthreads();
        for (int j = 0; j < 64; ++j) {
            float s = 0.f;
#pragma unroll
            for (int d = 0; d < 64; d += 4) { const float4 kv = *(const float4*)&ks[j][d]; s += q[d] * kv.x + q[d + 1] * kv.y + q[d + 2] * kv.z + q[d + 3] * kv.w; }
            if (s > m) { const float a = exp2f(m - s); l *= a;
#pragma unroll
                for (int d = 0; d < 64; ++d) o[d] *= a;
                m = s; }
            const float p = exp2f(s - m); l += p;
#pragma unroll
            for (int d = 0; d < 64; d += 4) { const float4 vv = *(const float4*)&vs[j][d]; o[d] += p * vv.x; o[d + 1] += p * vv.y; o[d + 2] += p * vv.z; o[d + 3] += p * vv.w; }
        }
    }
    const float il = 1.f / l;
#pragma unroll
    for (int c = 0; c < 8; ++c) { const uint4 gp = *(const uint4*)(GA + row * 512 + h * 64 + c * 8); uint4 w;
        w.x = f2bf(o[c * 8 + 0] * il * bf2f(gp.x & 0xffffu)) | (f2bf(o[c * 8 + 1] * il * bf2f(gp.x >> 16)) << 16);
        w.y = f2bf(o[c * 8 + 2] * il * bf2f(gp.y & 0xffffu)) | (f2bf(o[c * 8 + 3] * il * bf2f(gp.y >> 16)) << 16);
        w.z = f2bf(o[c * 8 + 4] * il * bf2f(gp.z & 0xffffu)) | (f2bf(o[c * 8 + 5] * il * bf2f(gp.z >> 16)) << 16);
        w.w = f2bf(o[c * 8 + 6] * il * bf2f(gp.w & 0xffffu)) | (f2bf(o[c * 8 + 7] * il * bf2f(gp.w >> 16)) << 16);
        *(uint4*)(QA + row * 512 + h * 64 + c * 8) = w; }
}

__global__ void __launch_bounds__(256) ret_naive(bf16_t* QR, const bf16_t* __restrict__ KR, const bf16_t* __restrict__ VR, const bf16_t* __restrict__ GR,
                                                 const float* __restrict__ dec_f, const float* __restrict__ dec_b, const float* __restrict__ gnw) {
    __shared__ float ks[32][128], vs[32][128];
    const int rb = blockIdx.x, h = blockIdx.y, b = blockIdx.z, tid = threadIdx.x, rloc = tid >> 2, sub = tid & 3;
    const int n = rb * 64 + rloc; const size_t row = (size_t)b * SEQ + n;
    float q[32], o[32];
#pragma unroll
    for (int c = 0; c < 4; ++c) { const uint4 p = *(const uint4*)(QR + row * 512 + h * 128 + sub * 32 + c * 8);
        q[c * 8 + 0] = bf2f(p.x & 0xffffu); q[c * 8 + 1] = bf2f(p.x >> 16); q[c * 8 + 2] = bf2f(p.y & 0xffffu); q[c * 8 + 3] = bf2f(p.y >> 16);
        q[c * 8 + 4] = bf2f(p.z & 0xffffu); q[c * 8 + 5] = bf2f(p.z >> 16); q[c * 8 + 6] = bf2f(p.w & 0xffffu); q[c * 8 + 7] = bf2f(p.w >> 16); }
#pragma unroll
    for (int d = 0; d < 32; ++d) o[d] = 0.f;
    const float lgf = -log2f(1.f + expf(-dec_f[h])), lgb = -log2f(1.f + expf(-dec_b[h]));
    for (int mt = 0; mt < SEQ / 32; ++mt) {
        __syncthreads();
        { const int key = tid >> 3, d0 = (tid & 7) * 16; const size_t krow = (size_t)b * SEQ + mt * 32 + key;
#pragma unroll
          for (int c = 0; c < 2; ++c) {
            const uint4 p = *(const uint4*)(KR + krow * 512 + h * 128 + d0 + c * 8);
            float* kd = &ks[key][d0 + c * 8];
            kd[0] = bf2f(p.x & 0xffffu); kd[1] = bf2f(p.x >> 16); kd[2] = bf2f(p.y & 0xffffu); kd[3] = bf2f(p.y >> 16); kd[4] = bf2f(p.z & 0xffffu); kd[5] = bf2f(p.z >> 16); kd[6] = bf2f(p.w & 0xffffu); kd[7] = bf2f(p.w >> 16);
            const uint4 u = *(const uint4*)(VR + krow * 512 + h * 128 + d0 + c * 8);
            float* vd = &vs[key][d0 + c * 8];
            vd[0] = bf2f(u.x & 0xffffu); vd[1] = bf2f(u.x >> 16); vd[2] = bf2f(u.y & 0xffffu); vd[3] = bf2f(u.y >> 16); vd[4] = bf2f(u.z & 0xffffu); vd[5] = bf2f(u.z >> 16); vd[6] = bf2f(u.w & 0xffffu); vd[7] = bf2f(u.w >> 16);
          } }
        __syncthreads();
        for (int j = 0; j < 32; ++j) {
            float s = 0.f;
#pragma unroll
            for (int d = 0; d < 32; d += 4) { const float4 kv = *(const float4*)&ks[j][sub * 32 + d]; s += q[d] * kv.x + q[d + 1] * kv.y + q[d + 2] * kv.z + q[d + 3] * kv.w; }
            s += __shfl_xor(s, 1); s += __shfl_xor(s, 2);
            const int diff = n - (mt * 32 + j);
            const float w = diff >= 0 ? exp2f((float)diff * lgf) : exp2f((float)(-diff) * lgb);
            s *= w;
#pragma unroll
            for (int d = 0; d < 32; d += 4) { const float4 vv = *(const float4*)&vs[j][sub * 32 + d]; o[d] += s * vv.x; o[d + 1] += s * vv.y; o[d + 2] += s * vv.z; o[d + 3] += s * vv.w; }
        }
    }
    float sm = 0.f;
#pragma unroll
    for (int d = 0; d < 32; ++d) sm += o[d];
    sm += __shfl_xor(sm, 1); sm += __shfl_xor(sm, 2);
    const float mean = sm * (1.f / 128.f);
    float vq = 0.f;
#pragma unroll
    for (int d = 0; d < 32; ++d) { const float t = o[d] - mean; vq += t * t; }
    vq += __shfl_xor(vq, 1); vq += __shfl_xor(vq, 2);
    const float rstd = rsqrtf(vq * (1.f / 128.f) + EPS);
#pragma unroll
    for (int c = 0; c < 4; ++c) { const int cb = h * 128 + sub * 32 + c * 8; const uint4 gp = *(const uint4*)(GR + row * 512 + cb); uint4 w;
        float y[8];
#pragma unroll
        for (int e = 0; e < 8; ++e) y[e] = (o[c * 8 + e] - mean) * rstd * gnw[cb + e];
        w.x = f2bf(y[0] * bf2f(gp.x & 0xffffu)) | (f2bf(y[1] * bf2f(gp.x >> 16)) << 16);
        w.y = f2bf(y[2] * bf2f(gp.y & 0xffffu)) | (f2bf(y[3] * bf2f(gp.y >> 16)) << 16);
        w.z = f2bf(y[4] * bf2f(gp.z & 0xffffu)) | (f2bf(y[5] * bf2f(gp.z >> 16)) << 16);
        w.w = f2bf(y[6] * bf2f(gp.w & 0xffffu)) | (f2bf(y[7] * bf2f(gp.w >> 16)) << 16);
        *(uint4*)(QR + row * 512 + cb) = w; }
}

__global__ void __launch_bounds__(64) branch_naive(const bf16_t* __restrict__ PA, const bf16_t* __restrict__ PR, const bf16_t* __restrict__ GM, const float* __restrict__ Wba, const float* __restrict__ Wbr, bf16_t* MG) {
    __shared__ float xs[16][260];
    const int g = blockIdx.x, r0 = blockIdx.y * 16, lane = threadIdx.x, col = g * 64 + lane;
    float ya[16], yb[16];
#pragma unroll
    for (int r = 0; r < 16; ++r) { ya[r] = 0.f; yb[r] = 0.f; }
    gemm16x64(PA, 512, 512, Wba, DM, r0, col, ya, xs);
    gemm16x64(PR, 512, 512, Wbr, DM, r0, col, yb, xs);
#pragma unroll
    for (int r = 0; r < 16; ++r) { const size_t row = (size_t)(r0 + r);
        const float sa = bf2f(GM[row * 2048 + col]), sb = bf2f(GM[row * 2048 + 1024 + col]);
        MG[row * 1024 + col] = (bf16_t)f2bf(sa * ya[r] + sb * yb[r]); }
}
__global__ void __launch_bounds__(64) outproj_naive(const bf16_t* __restrict__ MG, const float* __restrict__ Wout, const float* xin, float* xout) {
    __shared__ float xs[16][260];
    const int g = blockIdx.x, r0 = blockIdx.y * 16, lane = threadIdx.x, col = g * 64 + lane;
    float acc[16];
#pragma unroll
    for (int r = 0; r < 16; ++r) acc[r] = 0.f;
    gemm16x64(MG, DM, DM, Wout, DM, r0, col, acc, xs);
#pragma unroll
    for (int r = 0; r < 16; ++r) { const size_t idx = (size_t)(r0 + r) * DM + col; xout[idx] = xin[idx] + acc[r]; }
}

extern "C" void kernel_launch(void* const* d_in, const int* in_sizes, int n_in, void* d_out, int out_size, void* d_ws, size_t ws_size, hipStream_t stream) {
    if (n_in != 12 || out_size != M * DM || ws_size < WS_END) { fprintf(stderr, "kernel_launch: unexpected shapes n_in %d out %d ws %zu\n", n_in, out_size, ws_size); return; }
    const float* x = (const float*)d_in[0]; const float* norm_g = (const float*)d_in[1]; const float* w_in = (const float*)d_in[2];
    const float* qn = (const float*)d_in[3]; const float* kn = (const float*)d_in[4]; const float* dec_f = (const float*)d_in[5]; const float* dec_b = (const float*)d_in[6];
    const float* gnw = (const float*)d_in[7]; const float* wba = (const float*)d_in[8]; const float* wbr = (const float*)d_in[9]; const float* wout = (const float*)d_in[10]; const float* fng = (const float*)d_in[11];
    unsigned char* ws = (unsigned char*)d_ws; float* out = (float*)d_out;
    float* tab = (float*)(ws + WS_ROPE);
    bf16_t *XN = (bf16_t*)(ws + WS_XN), *QA = (bf16_t*)(ws + WS_QA), *KVA = (bf16_t*)(ws + WS_KVA), *GA = (bf16_t*)(ws + WS_GA), *QR = (bf16_t*)(ws + WS_QR), *KR = (bf16_t*)(ws + WS_KR),
           *VR = (bf16_t*)(ws + WS_VR), *GR = (bf16_t*)(ws + WS_GR), *GM = (bf16_t*)(ws + WS_GM), *MG = (bf16_t*)(ws + WS_MG);
    rope_tab_kernel<<<8, 256, 0, stream>>>(tab);
    for (int l = 0; l < DEPTH; ++l) {
        const float* xin = l == 0 ? x : out;
        norm_kernel<<<M / 4, 256, 0, stream>>>(xin, norm_g + l * DM, XN);
        inproj_naive<<<dim3(84, M / 16), 64, 0, stream>>>(XN, w_in + (size_t)l * DM * D_IN, qn + l * 64, kn + l * 64, tab, QA, KVA, GA, QR, KR, VR, GR, GM);
        attn_naive<<<dim3(SEQ / 64, 8, BATCH), 64, 0, stream>>>(QA, KVA, GA);
        ret_naive<<<dim3(SEQ / 64, 4, BATCH), 256, 0, stream>>>(QR, KR, VR, GR, dec_f + l * 4, dec_b + l * 4, gnw + l * 512);
        branch_naive<<<dim3(16, M / 16), 64, 0, stream>>>(QA, QR, GM, wba + (size_t)l * 512 * DM, wbr + (size_t)l * 512 * DM, MG);
        outproj_naive<<<dim3(16, M / 16), 64, 0, stream>>>(MG, wout + (size_t)l * DM * DM, xin, out);
    }
    final_norm_kernel<<<M / 4, 256, 0, stream>>>(out, fng, out);
}
```

```cpp
#include <hip/hip_runtime.h>
#include <cstdio>
#include <cstdint>

constexpr int BATCH = 8, SEQ = 4096, DM = 1024, DEPTH = 2, M = BATCH * SEQ, D_IN = 5376;
typedef unsigned short bf16_t;
constexpr float C2 = 0.125f * 1.4426950408889634f;
constexpr float EPS = 1e-6f;
constexpr float KSCALE = 0.08838834764831845f;

__device__ __forceinline__ float bf2f(unsigned v) { return __uint_as_float(v << 16); }
__device__ __forceinline__ unsigned f2bf(float f) { unsigned u = __float_as_uint(f); return (u + 0x7fffu + ((u >> 16) & 1u)) >> 16; }
__device__ __forceinline__ float wave_sum(float v) {
#pragma unroll
    for (int o = 1; o < 64; o <<= 1) v += __shfl_xor(v, o);
    return v;
}
__device__ __forceinline__ float silu_f(float v) { return v / (1.f + __expf(-v)); }
__device__ __forceinline__ float sigm_f(float v) { return 1.f / (1.f + __expf(-v)); }

constexpr size_t MiB = 1u << 20;
constexpr size_t WS_CTL = 0, CTL_ZERO_BYTES = 1 * MiB;
constexpr size_t WS_ROPE = 1 * MiB;
constexpr size_t WS_WIN = 2 * MiB, WIN_L = (size_t)D_IN * DM * 2;
constexpr size_t WS_WB = 24 * MiB, WB_L = (size_t)2048 * 512 * 2;
constexpr size_t WS_WOUT = 28 * MiB, WOUT_L = (size_t)DM * DM * 2;
constexpr size_t WS_XN = 32 * MiB, WS_QA = 96 * MiB, WS_KVA = 128 * MiB, WS_GA = 144 * MiB, WS_QR = 176 * MiB, WS_KR = 208 * MiB, WS_VR = 240 * MiB, WS_GR = 272 * MiB, WS_GM = 304 * MiB, WS_MG = WS_KR, WS_END = 432 * MiB;
constexpr size_t WS_ST = WS_XN;
constexpr size_t WS_PART = WS_XN;
static_assert(WS_WIN + 2 * WIN_L <= WS_WB && WS_WB + 2 * WB_L <= WS_WOUT && WS_WOUT + 2 * WOUT_L <= WS_XN, "weight map");

__global__ void rope_tab_kernel(float* tab) {
    const int i = threadIdx.x + blockIdx.x * blockDim.x;
    if (i < 1024) { const int p = i / 16, f = i % 16; const float inv = powf(10000.f, -(float)f / 16.f); const float a = (float)p * inv; tab[i] = cosf(a); tab[1024 + i] = sinf(a); }
    if (i < 2048) { const int p = i / 32, f = i % 32; const float inv = powf(10000.f, -(float)f / 32.f); const float a = (float)p * inv; tab[2048 + i] = cosf(a); tab[4096 + i] = sinf(a); }
}

__global__ void __launch_bounds__(256) norm_kernel(const float* __restrict__ x, const float* __restrict__ g, bf16_t* __restrict__ xn) {
    const int row = blockIdx.x * 4 + (threadIdx.x >> 6), lane = threadIdx.x & 63;
    const float4* xr = (const float4*)(x + (size_t)row * DM) + lane;
    float4 v[4]; float s = 0.f;
#pragma unroll
    for (int j = 0; j < 4; ++j) { v[j] = xr[64 * j]; s += v[j].x * v[j].x + v[j].y * v[j].y + v[j].z * v[j].z + v[j].w * v[j].w; }
    s = wave_sum(s);
    const float rstd = rsqrtf(s * (1.f / DM) + EPS);
    const float4* gr = (const float4*)g + lane;
#pragma unroll
    for (int j = 0; j < 4; ++j) { const float4 gg = gr[64 * j];
        uint2 o; o.x = f2bf(v[j].x * rstd * gg.x) | (f2bf(v[j].y * rstd * gg.y) << 16); o.y = f2bf(v[j].z * rstd * gg.z) | (f2bf(v[j].w * rstd * gg.w) << 16);
        *(uint2*)(xn + (size_t)row * DM + 4 * lane + 256 * j) = o; }
}
__global__ void __launch_bounds__(256) final_norm_kernel(const float* x, const float* __restrict__ g, float* out) {
    const int row = blockIdx.x * 4 + (threadIdx.x >> 6), lane = threadIdx.x & 63;
    const float4* xr = (const float4*)(x + (size_t)row * DM) + lane;
    float4 v[4]; float s = 0.f;
#pragma unroll
    for (int j = 0; j < 4; ++j) { v[j] = xr[64 * j]; s += v[j].x * v[j].x + v[j].y * v[j].y + v[j].z * v[j].z + v[j].w * v[j].w; }
    s = wave_sum(s);
    const float rstd = rsqrtf(s * (1.f / DM) + EPS);
    const float4* gr = (const float4*)g + lane;
#pragma unroll
    for (int j = 0; j < 4; ++j) { const float4 gg = gr[64 * j]; float4 o; o.x = v[j].x * rstd * gg.x; o.y = v[j].y * rstd * gg.y; o.z = v[j].z * rstd * gg.z; o.w = v[j].w * rstd * gg.w;
        *((float4*)(out + (size_t)row * DM) + lane + 64 * j) = o; }
}

__device__ __forceinline__ void gemm16x64(const bf16_t* __restrict__ A, int lda, int K, const float* __restrict__ W, int ldw, int r0, int col, float (&acc)[16], float (*xs)[260]) {
    const int lane = threadIdx.x;
    for (int k0 = 0; k0 < K; k0 += 256) {
        __syncthreads();
#pragma unroll
        for (int r = 0; r < 16; ++r) { const uint2 p = *(const uint2*)(A + (size_t)(r0 + r) * lda + k0 + lane * 4);
            float4 f; f.x = bf2f(p.x & 0xffffu); f.y = bf2f(p.x >> 16); f.z = bf2f(p.y & 0xffffu); f.w = bf2f(p.y >> 16); *(float4*)&xs[r][lane * 4] = f; }
        __syncthreads();
        for (int kk = 0; kk < 256; kk += 4) {
            const float* wp = W + (size_t)(k0 + kk) * ldw + col;
            const float w0 = wp[0], w1 = wp[ldw], w2 = wp[2 * (size_t)ldw], w3 = wp[3 * (size_t)ldw];
#pragma unroll
            for (int r = 0; r < 16; ++r) { const float4 xv = *(const float4*)&xs[r][kk]; acc[r] += xv.x * w0 + xv.y * w1 + xv.z * w2 + xv.w * w3; }
        }
    }
}

__global__ void __launch_bounds__(64) inproj_naive(const bf16_t* __restrict__ XN, const float* __restrict__ W, const float* __restrict__ qn, const float* __restrict__ kn, const float* __restrict__ tab,
                                                   bf16_t* QA, bf16_t* KVA, bf16_t* GA, bf16_t* QR, bf16_t* KR, bf16_t* VR, bf16_t* GR, bf16_t* GM) {
    __shared__ float xs[16][260];
    const int g = blockIdx.x, r0 = blockIdx.y * 16, lane = threadIdx.x;
    float acc[16];
#pragma unroll
    for (int r = 0; r < 16; ++r) acc[r] = 0.f;
    gemm16x64(XN, DM, DM, W, D_IN, r0, g * 64 + lane, acc, xs);
#pragma unroll
    for (int r = 0; r < 16; ++r) {
        const float v = acc[r]; const size_t row = (size_t)(r0 + r); const int t = (r0 + r) & (SEQ - 1), prow = t >> 6, pcol = t & 63;
        if (g < 10) {
            const float ss = wave_sum(v * v); const float rstd = rsqrtf(ss * (1.f / 64.f) + EPS);
            const float y = v * rstd * (g < 8 ? qn : kn)[lane];
            const int axis = lane >> 5, half = (lane >> 4) & 1, f = lane & 15, pos = axis ? pcol : prow;
            const float c = tab[pos * 16 + f], s = tab[1024 + pos * 16 + f];
            const float pr = __shfl_xor(y, 16);
            const float o = half == 0 ? y * c - pr * s : pr * s + y * c;
            if (g < 8) QA[row * 512 + g * 64 + lane] = (bf16_t)f2bf(o * C2); else KVA[row * 256 + (g - 8) * 64 + lane] = (bf16_t)f2bf(o);
        } else if (g < 12) { KVA[row * 256 + 128 + (g - 10) * 64 + lane] = (bf16_t)f2bf(v);
        } else if (g < 20) { GA[row * 512 + (g - 12) * 64 + lane] = (bf16_t)f2bf(silu_f(v));
        } else if (g < 36) {
            const int gg = (g - 20) & 7, axis = gg & 1, half = lane >> 5, f = lane & 31, pos = axis ? pcol : prow;
            const float c = tab[2048 + pos * 32 + f], s = tab[4096 + pos * 32 + f];
            const float pr = __shfl_xor(v, 32);
            const float o = half == 0 ? v * c - pr * s : pr * s + v * c;
            if (g < 28) QR[row * 512 + gg * 64 + lane] = (bf16_t)f2bf(o); else KR[row * 512 + gg * 64 + lane] = (bf16_t)f2bf(o * KSCALE);
        } else if (g < 44) { VR[row * 512 + (g - 36) * 64 + lane] = (bf16_t)f2bf(v);
        } else if (g < 52) { GR[row * 512 + (g - 44) * 64 + lane] = (bf16_t)f2bf(silu_f(v));
        } else { GM[row * 2048 + (g - 52) * 64 + lane] = (bf16_t)f2bf(sigm_f(v)); }
    }
}

__global__ void __launch_bounds__(64) attn_naive(bf16_t* QA, const bf16_t* __restrict__ KVA, const bf16_t* __restrict__ GA) {
    __shared__ float ks[64][64], vs[64][64];
    const int qb = blockIdx.x, h = blockIdx.y, b = blockIdx.z, lane = threadIdx.x, kvh = h >> 2;
    const size_t row = (size_t)b * SEQ + qb * 64 + lane;
    float q[64], o[64];
#pragma unroll
    for (int c = 0; c < 8; ++c) { const uint4 p = *(const uint4*)(QA + row * 512 + h * 64 + c * 8);
        q[c * 8 + 0] = bf2f(p.x & 0xffffu); q[c * 8 + 1] = bf2f(p.x >> 16); q[c * 8 + 2] = bf2f(p.y & 0xffffu); q[c * 8 + 3] = bf2f(p.y >> 16);
        q[c * 8 + 4] = bf2f(p.z & 0xffffu); q[c * 8 + 5] = bf2f(p.z >> 16); q[c * 8 + 6] = bf2f(p.w & 0xffffu); q[c * 8 + 7] = bf2f(p.w >> 16); }
#pragma unroll
    for (int d = 0; d < 64; ++d) o[d] = 0.f;
    float m = -INFINITY, l = 0.f;
    for (int kt = 0; kt < SEQ / 64; ++kt) {
        __syncthreads();
        const size_t krow = (size_t)b * SEQ + kt * 64 + lane;
#pragma unroll
        for (int c = 0; c < 8; ++c) {
            const uint4 p = *(const uint4*)(KVA + krow * 256 + kvh * 64 + c * 8);
            ks[lane][c * 8 + 0] = bf2f(p.x & 0xffffu); ks[lane][c * 8 + 1] = bf2f(p.x >> 16); ks[lane][c * 8 + 2] = bf2f(p.y & 0xffffu); ks[lane][c * 8 + 3] = bf2f(p.y >> 16);
            ks[lane][c * 8 + 4] = bf2f(p.z & 0xffffu); ks[lane][c * 8 + 5] = bf2f(p.z >> 16); ks[lane][c * 8 + 6] = bf2f(p.w & 0xffffu); ks[lane][c * 8 + 7] = bf2f(p.w >> 16);
            const uint4 u = *(const uint4*)(KVA + krow * 256 + 128 + kvh * 64 + c * 8);
            vs[lane][c * 8 + 0] = bf2f(u.x & 0xffffu); vs[lane][c * 8 + 1] = bf2f(u.x >> 16); vs[lane][c * 8 + 2] = bf2f(u.y & 0xffffu); vs[lane][c * 8 + 3] = bf2f(u.y >> 16);
            vs[lane][c * 8 + 4] = bf2f(u.z & 0xffffu); vs[lane][c * 8 + 5] = bf2f(u.z >> 16); vs[lane][c * 8 + 6] = bf2f(u.w & 0xffffu); vs[lane][c * 8 + 7] = bf2f(u.w >> 16);
        }
        __syncthreads();
        for (int j = 0; j < 64; ++j) {
            float s = 0.f;
#pragma unroll
            for (int d = 0; d < 64; d += 4) { const float4 kv = *(const float4*)&ks[j][d]; s += q[d] * kv.x + q[d + 1] * kv.y + q[d + 2] * kv.z + q[d + 3] * kv.w; }
            if (s > m) { const float a = exp2f(m - s); l *= a;
#pragma unroll
                for (int d = 0; d < 64; ++d) o[d] *= a;
                m = s; }
            const float p = exp2f(s - m); l += p;
#pragma unroll
            for (int d = 0; d < 64; d += 4) { const float4 vv = *(const float4*)&vs[j][d]; o[d] += p * vv.x; o[d + 1] += p * vv.y; o[d + 2] += p * vv.z; o[d + 3] += p * vv.w; }
        }
    }
    const float il = 1.f / l;
#pragma unroll
    for (int c = 0; c < 8; ++c) { const uint4 gp = *(const uint4*)(GA + row * 512 + h * 64 + c * 8); uint4 w;
        w.x = f2bf(o[c * 8 + 0] * il * bf2f(gp.x & 0xffffu)) | (f2bf(o[c * 8 + 1] * il * bf2f(gp.x >> 16)) << 16);
        w.y = f2bf(o[c * 8 + 2] * il * bf2f(gp.y & 0xffffu)) | (f2bf(o[c * 8 + 3] * il * bf2f(gp.y >> 16)) << 16);
        w.z = f2bf(o[c * 8 + 4] * il * bf2f(gp.z & 0xffffu)) | (f2bf(o[c * 8 + 5] * il * bf2f(gp.z >> 16)) << 16);
        w.w = f2bf(o[c * 8 + 6] * il * bf2f(gp.w & 0xffffu)) | (f2bf(o[c * 8 + 7] * il * bf2f(gp.w >> 16)) << 16);
        *(uint4*)(QA + row * 512 + h * 64 + c * 8) = w; }
}

__global__ void __launch_bounds__(256) ret_naive(bf16_t* QR, const bf16_t* __restrict__ KR, const bf16_t* __restrict__ VR, const bf16_t* __restrict__ GR,
                                                 const float* __restrict__ dec_f, const float* __restrict__ dec_b, const float* __restrict__ gnw) {
    __shared__ float ks[32][128], vs[32][128];
    const int rb = blockIdx.x, h = blockIdx.y, b = blockIdx.z, tid = threadIdx.x, rloc = tid >> 2, sub = tid & 3;
    const int n = rb * 64 + rloc; const size_t row = (size_t)b * SEQ + n;
    float q[32], o[32];
#pragma unroll
    for (int c = 0; c < 4; ++c) { const uint4 p = *(const uint4*)(QR + row * 512 + h * 128 + sub * 32 + c * 8);
        q[c * 8 + 0] = bf2f(p.x & 0xffffu); q[c * 8 + 1] = bf2f(p.x >> 16); q[c * 8 + 2] = bf2f(p.y & 0xffffu); q[c * 8 + 3] = bf2f(p.y >> 16);
        q[c * 8 + 4] = bf2f(p.z & 0xffffu); q[c * 8 + 5] = bf2f(p.z >> 16); q[c * 8 + 6] = bf2f(p.w & 0xffffu); q[c * 8 + 7] = bf2f(p.w >> 16); }
#pragma unroll
    for (int d = 0; d < 32; ++d) o[d] = 0.f;
    const float lgf = -log2f(1.f + expf(-dec_f[h])), lgb = -log2f(1.f + expf(-dec_b[h]));
    for (int mt = 0; mt < SEQ / 32; ++mt) {
        __syncthreads();
        { const int key = tid >> 3, d0 = (tid & 7) * 16; const size_t krow = (size_t)b * SEQ + mt * 32 + key;
#pragma unroll
          for (int c = 0; c < 2; ++c) {
            const uint4 p = *(const uint4*)(KR + krow * 512 + h * 128 + d0 + c * 8);
            float* kd = &ks[key][d0 + c * 8];
            kd[0] = bf2f(p.x & 0xffffu); kd[1] = bf2f(p.x >> 16); kd[2] = bf2f(p.y & 0xffffu); kd[3] = bf2f(p.y >> 16); kd[4] = bf2f(p.z & 0xffffu); kd[5] = bf2f(p.z >> 16); kd[6] = bf2f(p.w & 0xffffu); kd[7] = bf2f(p.w >> 16);
            const uint4 u = *(const uint4*)(VR + krow * 512 + h * 128 + d0 + c * 8);
            float* vd = &vs[key][d0 + c * 8];
            vd[0] = bf2f(u.x & 0xffffu); vd[1] = bf2f(u.x >> 16); vd[2] = bf2f(u.y & 0xffffu); vd[3] = bf2f(u.y >> 16); vd[4] = bf2f(u.z & 0xffffu); vd[5] = bf2f(u.z >> 16); vd[6] = bf2f(u.w & 0xffffu); vd[7] = bf2f(u.w >> 16);
          } }
        __syncthreads();
        for (int j = 0; j < 32; ++j) {
            float s = 0.f;
#pragma unroll
            for (int d = 0; d < 32; d += 4) { const float4 kv = *(const float4*)&ks[j][sub * 32 + d]; s += q[d] * kv.x + q[d + 1] * kv.y + q[d + 2] * kv.z + q[d + 3] * kv.w; }
            s += __shfl_xor(s, 1); s += __shfl_xor(s, 2);
            const int diff = n - (mt * 32 + j);
            const float w = diff >= 0 ? exp2f((float)diff * lgf) : exp2f((float)(-diff) * lgb);
            s *= w;
#pragma unroll
            for (int d = 0; d < 32; d += 4) { const float4 vv = *(const float4*)&vs[j][sub * 32 + d]; o[d] += s * vv.x; o[d + 1] += s * vv.y; o[d + 2] += s * vv.z; o[d + 3] += s * vv.w; }
        }
    }
    float sm = 0.f;
#pragma unroll
    for (int d = 0; d < 32; ++d) sm += o[d];
    sm += __shfl_xor(sm, 1); sm += __shfl_xor(sm, 2);
    const float mean = sm * (1.f / 128.f);
    float vq = 0.f;
#pragma unroll
    for (int d = 0; d < 32; ++d) { const float t = o[d] - mean; vq += t * t; }
    vq += __shfl_xor(vq, 1); vq += __shfl_xor(vq, 2);
    const float rstd = rsqrtf(vq * (1.f / 128.f) + EPS);
#pragma unroll
    for (int c = 0; c < 4; ++c) { const int cb = h * 128 + sub * 32 + c * 8; const uint4 gp = *(const uint4*)(GR + row * 512 + cb); uint4 w;
        float y[8];
#pragma unroll
        for (int e = 0; e < 8; ++e) y[e] = (o[c * 8 + e] - mean) * rstd * gnw[cb + e];
        w.x = f2bf(y[0] * bf2f(gp.x & 0xffffu)) | (f2bf(y[1] * bf2f(gp.x >> 16)) << 16);
        w.y = f2bf(y[2] * bf2f(gp.y & 0xffffu)) | (f2bf(y[3] * bf2f(gp.y >> 16)) << 16);
        w.z = f2bf(y[4] * bf2f(gp.z & 0xffffu)) | (f2bf(y[5] * bf2f(gp.z >> 16)) << 16);
        w.w = f2bf(y[6] * bf2f(gp.w & 0xffffu)) | (f2bf(y[7] * bf2f(gp.w >> 16)) << 16);
        *(uint4*)(QR + row * 512 + cb) = w; }
}

__global__ void __launch_bounds__(64) branch_naive(const bf16_t* __restrict__ PA, const bf16_t* __restrict__ PR, const bf16_t* __restrict__ GM, const float* __restrict__ Wba, const float* __restrict__ Wbr, bf16_t* MG) {
    __shared__ float xs[16][260];
    const int g = blockIdx.x, r0 = blockIdx.y * 16, lane = threadIdx.x, col = g * 64 + lane;
    float ya[16], yb[16];
#pragma unroll
    for (int r = 0; r < 16; ++r) { ya[r] = 0.f; yb[r] = 0.f; }
    gemm16x64(PA, 512, 512, Wba, DM, r0, col, ya, xs);
    gemm16x64(PR, 512, 512, Wbr, DM, r0, col, yb, xs);
#pragma unroll
    for (int r = 0; r < 16; ++r) { const size_t row = (size_t)(r0 + r);
        const float sa = bf2f(GM[row * 2048 + col]), sb = bf2f(GM[row * 2048 + 1024 + col]);
        MG[row * 1024 + col] = (bf16_t)f2bf(sa * ya[r] + sb * yb[r]); }
}
__global__ void __launch_bounds__(64) outproj_naive(const bf16_t* __restrict__ MG, const float* __restrict__ Wout, const float* xin, float* xout) {
    __shared__ float xs[16][260];
    const int g = blockIdx.x, r0 = blockIdx.y * 16, lane = threadIdx.x, col = g * 64 + lane;
    float acc[16];
#pragma unroll
    for (int r = 0; r < 16; ++r) acc[r] = 0.f;
    gemm16x64(MG, DM, DM, Wout, DM, r0, col, acc, xs);
#pragma unroll
    for (int r = 0; r < 16; ++r) { const size_t idx = (size_t)(r0 + r) * DM + col; xout[idx] = xin[idx] + acc[r]; }
}
namespace pg8 {
#define PG8_LAS __attribute__((address_space(3)))
typedef unsigned short bf16_t;
typedef short bf16x8 __attribute__((ext_vector_type(8)));
typedef float f32x4 __attribute__((ext_vector_type(4)));
typedef unsigned u32x4 __attribute__((ext_vector_type(4)));
constexpr int BM = 256, BK = 64, HALF = 128, HTB = HALF * BK * 2  , STAGE_BYTES = 8 * HTB, NXCD = 8, WGM = 8;

__host__ __device__ __forceinline__ int lds_byte(int r, int c) { const int st = (r >> 4) * 2 + (c >> 5), rr = r & 15, cc = c & 31, ob = rr * 64 + cc * 2; return st * 1024 + (ob ^ (((ob >> 9) & 1) << 5)); }
__host__ __device__ __forceinline__ void stage_rc(int b, int& R, int& C) { const int st = b / 1024, sb = b % 1024, swz = sb ^ (((sb >> 9) & 1) << 5); R = (st >> 1) * 16 + swz / 64; C = (st & 1) * 32 + (swz % 64) / 2; }
__host__ __device__ __forceinline__ int perm32(int rho) { const int n = rho >> 4, i = rho & 15; return 8 * (i >> 2) + 4 * n + (i & 3); }

struct Unit { int pm, pn; };
struct Gemm { const bf16_t* A; const bf16_t* Bt; int M, N, K; };

struct StaticOrder {
    int nM, nN, nwg, G, c;
    __host__ __device__ void init(int M, int N, int G_, int c_) { nM = M / BM; nN = N / BM; nwg = nM * nN; G = G_; c = c_; }
    __host__ __device__ bool next(int i, Unit& u) const {
        const long L = (long)i * G + c; if (L >= nwg) return false;
        int wgid = (int)L; { const int q = nwg / NXCD, r = nwg % NXCD, xcd = wgid % NXCD, off = wgid / NXCD; wgid = (xcd < r ? xcd * (q + 1) : r * (q + 1) + (xcd - r) * q) + off; }
        const int nig = WGM * nN, gid = wgid / nig, fm = gid * WGM, gsz = (nM - fm) < WGM ? (nM - fm) : WGM;
        u.pm = fm + ((wgid % nig) % gsz); u.pn = (wgid % nig) / gsz; return true;
    }
    __device__ __forceinline__ void a_ready(const Unit&) const {}
    __device__ __forceinline__ void done(const Unit&) const {}
};
__device__ __forceinline__ unsigned cvt_pk_bf16(float lo, float hi) { unsigned r; asm volatile("v_cvt_pk_bf16_f32 %0, %1, %2" : "=v"(r) : "v"(lo), "v"(hi)); return r; }
typedef unsigned u32x2 __attribute__((ext_vector_type(2)));
__device__ __forceinline__ void st_bf16x4(bf16_t* p, f32x4 v) { u32x2 w; w.x = cvt_pk_bf16(v[0], v[1]); w.y = cvt_pk_bf16(v[2], v[3]); *(u32x2*)p = w; }
__device__ __forceinline__ float dot4(f32x4 a) { return (a[0] * a[0] + a[1] * a[1]) + (a[2] * a[2] + a[3] * a[3]); }
__device__ __forceinline__ f32x4 act4(f32x4 v, int act) {
    f32x4 o;
#pragma unroll
    for (int j = 0; j < 4; ++j) { const float sg = __builtin_amdgcn_rcpf(1.f + __builtin_amdgcn_exp2f(-1.4426950408889634f * v[j])); o[j] = act == 0 ? v[j] : (act == 1 ? v[j] * sg : sg); }
    return o;
}

struct EpiInProj {
    static constexpr bool PERM = false, AFTER_DRAIN = false;
    bf16_t *QA, *KVA, *GA, *QR, *KR, *VR, *GR, *GM; const float* qn; const float* kn; const PG8_LAS float* tab;
    __device__ __forceinline__ void operator()(const f32x4 (&acc)[2][2][4][2], const Unit& u, int wr, int wc, int fr, int fq) const {
        const int pn = u.pn; const size_t rowb = (size_t)u.pm * BM + wr * 64 + fr; const int prow0 = 4 * u.pm + wr;
        if (pn < 2 || (pn == 2 && wc < 2)) {
            const bool isq = pn < 2; const float* gn = isq ? qn : kn;
            bf16_t* dst = isq ? QA + 256 * pn + 64 * wc : KVA + 64 * wc; const int pitch = isq ? 512 : 256; const float osc = isq ? C2 : 1.f;
            f32x4 gv[2][2];
#pragma unroll
            for (int bj = 0; bj < 2; ++bj)
#pragma unroll
                for (int n = 0; n < 2; ++n) gv[bj][n] = *(const f32x4*)(gn + 32 * bj + 16 * n + 4 * fq);
#pragma unroll
            for (int ai = 0; ai < 2; ++ai) {
                const int prow = (prow0 + 2 * ai) & 63;
                const f32x4 c0 = *(const PG8_LAS f32x4*)(tab + prow * 16 + 4 * fq), s0 = *(const PG8_LAS f32x4*)(tab + 1024 + prow * 16 + 4 * fq);
#pragma unroll
                for (int m = 0; m < 4; ++m) {
                    const int pcol = 16 * m + fr;
                    const f32x4 c1 = *(const PG8_LAS f32x4*)(tab + pcol * 16 + 4 * fq), s1 = *(const PG8_LAS f32x4*)(tab + 1024 + pcol * 16 + 4 * fq);
                    const f32x4 x00 = acc[ai][0][m][0], x01 = acc[ai][0][m][1], x10 = acc[ai][1][m][0], x11 = acc[ai][1][m][1];
                    float ss = (dot4(x00) + dot4(x01)) + (dot4(x10) + dot4(x11));
                    ss += __shfl_xor(ss, 16); ss += __shfl_xor(ss, 32);
                    const float rs = rsqrtf(ss * (1.f / 64.f) + EPS) * osc;
                    const f32x4 y00 = x00 * rs * gv[0][0], y01 = x01 * rs * gv[0][1], y10 = x10 * rs * gv[1][0], y11 = x11 * rs * gv[1][1];
                    bf16_t* rp = dst + (rowb + ai * HALF + m * 16) * pitch + 4 * fq;
                    st_bf16x4(rp, y00 * c0 - y01 * s0); st_bf16x4(rp + 16, y00 * s0 + y01 * c0);
                    st_bf16x4(rp + 32, y10 * c1 - y11 * s1); st_bf16x4(rp + 48, y10 * s1 + y11 * c1);
                    asm volatile("" ::: "memory");
                }
            }
        } else if (pn >= 5 && pn < 9) {
            const bool isq = pn < 7; const int axis = wc & 1; const float osc = isq ? 1.f : KSCALE;
            bf16_t* dst = (isq ? QR + 256 * (pn - 5) : KR + 256 * (pn - 7)) + 64 * wc;
#pragma unroll
            for (int ai = 0; ai < 2; ++ai) {
                const int prow = (prow0 + 2 * ai) & 63;
#pragma unroll
                for (int m = 0; m < 4; ++m) {
                    const int pos = axis ? 16 * m + fr : prow;
                    bf16_t* rp = dst + (rowb + ai * HALF + m * 16) * 512 + 4 * fq;
#pragma unroll
                    for (int n = 0; n < 2; ++n) {
                        const f32x4 c = *(const PG8_LAS f32x4*)(tab + 2048 + pos * 32 + 16 * n + 4 * fq), s = *(const PG8_LAS f32x4*)(tab + 4096 + pos * 32 + 16 * n + 4 * fq);
                        const f32x4 x0 = acc[ai][0][m][n] * osc, x1 = acc[ai][1][m][n] * osc;
                        st_bf16x4(rp + 16 * n, x0 * c - x1 * s); st_bf16x4(rp + 32 + 16 * n, x0 * s + x1 * c);
                    }
                    asm volatile("" ::: "memory");
                }
            }
        } else {
            bf16_t* dst; int pitch = 512, act = 0;
            if (pn == 2) { dst = KVA; pitch = 256; }
            else if (pn < 5) { dst = GA + 256 * (pn - 3); act = 1; }
            else if (pn < 11) { dst = VR + 256 * (pn - 9); }
            else if (pn < 13) { dst = GR + 256 * (pn - 11); act = 1; }
            else { dst = GM + 256 * (pn - 13); pitch = 2048; act = 2; }
            dst += 64 * wc + 8 * fq;
#pragma unroll
            for (int ai = 0; ai < 2; ++ai)
#pragma unroll
                for (int m = 0; m < 4; ++m) { bf16_t* rp = dst + (rowb + ai * HALF + m * 16) * pitch;
#pragma unroll
                    for (int bj = 0; bj < 2; ++bj) { const f32x4 v0 = act4(acc[ai][bj][m][0], act), v1 = act4(acc[ai][bj][m][1], act);
                        u32x4 w; w.x = cvt_pk_bf16(v0[0], v0[1]); w.y = cvt_pk_bf16(v0[2], v0[3]); w.z = cvt_pk_bf16(v1[0], v1[1]); w.w = cvt_pk_bf16(v1[2], v1[3]);
                        *(u32x4*)(rp + 32 * bj) = w; }
                    asm volatile("" ::: "memory"); }
        }
    }
};

struct EpiBranch {
    static constexpr bool PERM = false, AFTER_DRAIN = false;
    const bf16_t* GM; bf16_t* MG;
    __device__ __forceinline__ void operator()(const f32x4 (&acc)[2][2][4][2], const Unit& u, int wr, int wc, int fr, int fq) const {
        const bool second = u.pn >= 4; const int pm = second ? u.pm - 320 : u.pm, pn = second ? u.pn - 4 : u.pn;
        const size_t rowb = (size_t)pm * BM + wr * 64 + fr; const int colb = 256 * pn + 64 * wc + 8 * fq;
        const bf16_t* gp = GM + (second ? 1024 : 0) + colb; bf16_t* mp = MG + colb;
#pragma unroll
        for (int ai = 0; ai < 2; ++ai)
#pragma unroll
            for (int m = 0; m < 4; ++m) { const size_t row = rowb + ai * HALF + m * 16;
#pragma unroll
                for (int bj = 0; bj < 2; ++bj) {
                    const u32x4 gw = *(const u32x4*)(gp + row * 2048 + 32 * bj);
                    f32x4 g0, g1; g0[0] = __uint_as_float(gw.x << 16); g0[1] = __uint_as_float(gw.x & 0xffff0000u); g0[2] = __uint_as_float(gw.y << 16); g0[3] = __uint_as_float(gw.y & 0xffff0000u);
                    g1[0] = __uint_as_float(gw.z << 16); g1[1] = __uint_as_float(gw.z & 0xffff0000u); g1[2] = __uint_as_float(gw.w << 16); g1[3] = __uint_as_float(gw.w & 0xffff0000u);
                    f32x4 v0 = g0 * acc[ai][bj][m][0], v1 = g1 * acc[ai][bj][m][1];
                    u32x4* op = (u32x4*)(mp + row * 1024 + 32 * bj);
                    if (second) { const u32x4 pw = *op;
                        v0[0] += __uint_as_float(pw.x << 16); v0[1] += __uint_as_float(pw.x & 0xffff0000u); v0[2] += __uint_as_float(pw.y << 16); v0[3] += __uint_as_float(pw.y & 0xffff0000u);
                        v1[0] += __uint_as_float(pw.z << 16); v1[1] += __uint_as_float(pw.z & 0xffff0000u); v1[2] += __uint_as_float(pw.w << 16); v1[3] += __uint_as_float(pw.w & 0xffff0000u); }
                    u32x4 w; w.x = cvt_pk_bf16(v0[0], v0[1]); w.y = cvt_pk_bf16(v0[2], v0[3]); w.z = cvt_pk_bf16(v1[0], v1[1]); w.w = cvt_pk_bf16(v1[2], v1[3]);
                    *op = w;
                }
                asm volatile("" ::: "memory"); }
    }
};
struct BranchOrder {
    int G, c;
    __device__ bool next(int i, Unit& u) const {
        const int t = (i >> 1) * G + c; if (t >= 512) return false;
        const int x = t & 7, o = t >> 3;
        const int lin = x * 64 + o, pm = lin >> 2, pn = lin & 3;
        u.pm = (i & 1) ? pm + 320 : pm; u.pn = (i & 1) ? pn + 4 : pn; return true;
    }
    __device__ __forceinline__ void a_ready(const Unit&) const {}
    __device__ __forceinline__ void done(const Unit&) const {}
};

struct EpiOut {
    static constexpr bool PERM = false, AFTER_DRAIN = false;
    const float* xin; float* xout;
    __device__ __forceinline__ void operator()(const f32x4 (&acc)[2][2][4][2], const Unit& u, int wr, int wc, int fr, int fq) const {
        const size_t rowb = (size_t)u.pm * BM + wr * 64 + fr; const int colb = 256 * u.pn + 64 * wc + 4 * fq;
#pragma unroll
        for (int ai = 0; ai < 2; ++ai)
#pragma unroll
            for (int m = 0; m < 4; ++m) { const size_t off = (rowb + ai * HALF + m * 16) * DM + colb;
#pragma unroll
                for (int bj = 0; bj < 2; ++bj)
#pragma unroll
                    for (int n = 0; n < 2; ++n) { const f32x4 b = *(const f32x4*)(xin + off + 32 * bj + 16 * n); *(f32x4*)(xout + off + 32 * bj + 16 * n) = b + acc[ai][bj][m][n]; } }
    }
};

template <class Epi, class Sched, bool ALIGN_EPI = false, bool SP2 = false>
__device__ __forceinline__ void gemm_phase(PG8_LAS unsigned char* lds, const Gemm g, const Sched& S, const Epi& E) {
    int tid_ = threadIdx.x; asm volatile("" : "+v"(tid_));
    const int tid = tid_, wid = __builtin_amdgcn_readfirstlane(tid >> 6), lane = tid & 63, wr = wid >> 2, wc = wid & 3, fr = lane & 15, fq = lane >> 4;
    const int K = g.K, nt = K / BK;
    unsigned voffA[2], voffB[2];
#pragma unroll
    for (int i = 0; i < 2; ++i) { int R, C; stage_rc(tid * 16 + i * 8192, R, C); const int Rb = Epi::PERM ? ((R & ~31) + perm32(R & 31)) : R;
        voffA[i] = (unsigned)(R * K + C) * 2u; voffB[i] = (unsigned)(Rb * K + C) * 2u; }
    const size_t kstep = (size_t)(BK * 2);
    const size_t hstep = (size_t)HALF * K * 2;
    const size_t tstep = 2 * hstep;
    const unsigned ldsw = (unsigned)wid * 1024u;
    const int aoff = lds_byte(wr * 64 + fr, fq * 8), boff = lds_byte(wc * 32 + fr, fq * 8);
#define PG8_SA(b, h) (((b) * 2 + (h)) * HTB)
#define PG8_SB(b, h) ((4 + (b) * 2 + (h)) * HTB)
#define PG8_STAGE(bufoff, gbase, voff) do { _Pragma("unroll") for (int _i = 0; _i < 2; ++_i) \
        __builtin_amdgcn_global_load_lds((const unsigned*)((const char*)(gbase) + (voff)[_i]), (PG8_LAS unsigned*)(lds + (bufoff) + ldsw + _i * 8192), 16, 0, 0); } while (0)
#define PG8_LDA(dst, b, h) do { _Pragma("unroll") for (int m = 0; m < 4; ++m) _Pragma("unroll") for (int k = 0; k < 2; ++k) dst[m][k] = *(const PG8_LAS bf16x8*)(lds + PG8_SA(b, h) + aoff + m * 2048 + k * 1024); } while (0)
#define PG8_LDB(dst, b, h) do { _Pragma("unroll") for (int n = 0; n < 2; ++n) _Pragma("unroll") for (int k = 0; k < 2; ++k) dst[n][k] = *(const PG8_LAS bf16x8*)(lds + PG8_SB(b, h) + boff + n * 2048 + k * 1024); } while (0)
#define PG8_MMA(ai, bj, At, Bt) do { __builtin_amdgcn_s_setprio(1); _Pragma("unroll") for (int m = 0; m < 4; ++m) _Pragma("unroll") for (int n = 0; n < 2; ++n) _Pragma("unroll") for (int k = 0; k < 2; ++k) \
        acc[ai][bj][m][n] = __builtin_amdgcn_mfma_f32_16x16x32_bf16(Bt[n][k], At[m][k], acc[ai][bj][m][n], 0, 0, 0); __builtin_amdgcn_s_setprio(0); } while (0)
#define PG8_WAIT_V(n) asm volatile("s_waitcnt vmcnt(" #n ")" ::: "memory")
#define PG8_WAIT_L(n) asm volatile("s_waitcnt lgkmcnt(" #n ")" ::: "memory")
#define PG8_BAR __builtin_amdgcn_s_barrier()
#define PG8_SCHED __builtin_amdgcn_sched_barrier(0)
    Unit cur, nxt; int ui = 0;
    if (!S.next(0, cur)) return;
    f32x4 acc[2][2][4][2];
#pragma unroll
    for (int a = 0; a < 2; ++a)
#pragma unroll
        for (int b = 0; b < 2; ++b)
#pragma unroll
            for (int m = 0; m < 4; ++m)
#pragma unroll
                for (int n = 0; n < 2; ++n) acc[a][b][m][n] = (f32x4){0.f, 0.f, 0.f, 0.f};
    bf16x8 At[4][2], B0[2][2], B1[2][2];
    const char* cA = (const char*)g.A + (size_t)cur.pm * tstep; const char* cB = (const char*)g.Bt + (size_t)cur.pn * tstep;
    S.a_ready(cur);
    if constexpr (SP2) {
        PG8_STAGE(PG8_SB(0, 0), cB, voffB); PG8_STAGE(PG8_SB(0, 1), cB + hstep, voffB); PG8_STAGE(PG8_SA(0, 0), cA, voffA); PG8_STAGE(PG8_SA(0, 1), cA + hstep, voffA);
        if (wr == 1) PG8_BAR;
        PG8_WAIT_V(2); PG8_BAR;
        PG8_STAGE(PG8_SB(1, 0), cB + kstep, voffB); PG8_STAGE(PG8_SA(1, 0), cA + kstep, voffA); PG8_STAGE(PG8_SB(1, 1), cB + hstep + kstep, voffB);
        PG8_WAIT_V(6); PG8_BAR;
    } else {
        PG8_STAGE(PG8_SB(0, 0), cB, voffB); PG8_STAGE(PG8_SA(0, 0), cA, voffA); PG8_STAGE(PG8_SB(0, 1), cB + hstep, voffB); PG8_STAGE(PG8_SA(0, 1), cA + hstep, voffA);
        if (wr == 1) PG8_BAR;
        PG8_WAIT_V(4); PG8_BAR;
        PG8_STAGE(PG8_SB(1, 0), cB + kstep, voffB); PG8_STAGE(PG8_SA(1, 0), cA + kstep, voffA); PG8_STAGE(PG8_SB(1, 1), cB + hstep + kstep, voffB);
        PG8_WAIT_V(6); PG8_BAR;
    }
    for (;;) {
        const bool has_next = S.next(ui + 1, nxt);
        const char* nA = has_next ? (const char*)g.A + (size_t)nxt.pm * tstep : cA; const char* nB = has_next ? (const char*)g.Bt + (size_t)nxt.pn * tstep : cB;
        for (int t = 0; t < nt; t += 2) {
            const bool last = (t == nt - 2);
            const char* a1 = cA + (size_t)(t + 1) * kstep;
            const char* a2 = last ? nA : cA + (size_t)(t + 2) * kstep; const char* b2 = last ? nB : cB + (size_t)(t + 2) * kstep;
            const char* a3 = a2 + kstep; const char* b3 = b2 + kstep;
            if (last && has_next) S.a_ready(nxt);
            if constexpr (SP2) {
            PG8_LDB(B0, 0, 0); PG8_LDB(B1, 0, 1); PG8_SCHED; PG8_LDA(At, 0, 0); PG8_STAGE(PG8_SA(1, 1), a1 + hstep, voffA);
            PG8_WAIT_V(8); PG8_WAIT_L(0); PG8_BAR; PG8_MMA(0, 0, At, B0); PG8_MMA(0, 1, At, B1); PG8_BAR; PG8_SCHED;
            PG8_LDA(At, 0, 1); PG8_STAGE(PG8_SB(0, 0), b2, voffB); PG8_STAGE(PG8_SB(0, 1), b2 + hstep, voffB); PG8_STAGE(PG8_SA(0, 0), a2, voffA);
            PG8_WAIT_V(8); PG8_WAIT_L(0); PG8_BAR; PG8_MMA(1, 0, At, B0); PG8_MMA(1, 1, At, B1); PG8_BAR; PG8_SCHED;
            PG8_LDB(B0, 1, 0); PG8_LDB(B1, 1, 1); PG8_SCHED; PG8_LDA(At, 1, 0); PG8_STAGE(PG8_SA(0, 1), a2 + hstep, voffA);
            PG8_WAIT_V(8); PG8_WAIT_L(0); PG8_BAR; PG8_MMA(0, 0, At, B0); PG8_MMA(0, 1, At, B1); PG8_BAR; PG8_SCHED;
            PG8_LDA(At, 1, 1); PG8_STAGE(PG8_SB(1, 0), b3, voffB); PG8_STAGE(PG8_SB(1, 1), b3 + hstep, voffB); PG8_STAGE(PG8_SA(1, 0), a3, voffA);
            PG8_WAIT_V(8); PG8_WAIT_L(0); PG8_BAR; PG8_MMA(1, 0, At, B0); PG8_MMA(1, 1, At, B1); PG8_BAR; PG8_SCHED;
            } else {
            PG8_LDB(B0, 0, 0); PG8_SCHED; PG8_LDA(At, 0, 0); PG8_STAGE(PG8_SA(1, 1), a1 + hstep, voffA);
            PG8_WAIT_L(8); PG8_BAR; PG8_WAIT_L(0); PG8_MMA(0, 0, At, B0); PG8_BAR; PG8_SCHED;
            PG8_LDB(B1, 0, 1); PG8_STAGE(PG8_SB(0, 0), b2, voffB);
            PG8_BAR; PG8_WAIT_L(0); PG8_MMA(0, 1, At, B1); PG8_BAR;
            PG8_LDA(At, 0, 1); PG8_STAGE(PG8_SA(0, 0), a2, voffA);
            PG8_BAR; PG8_WAIT_L(0); PG8_MMA(1, 0, At, B0); PG8_BAR; PG8_SCHED;
            PG8_STAGE(PG8_SB(0, 1), b2 + hstep, voffB);
            PG8_WAIT_V(6); PG8_BAR; PG8_MMA(1, 1, At, B1); PG8_BAR;
            PG8_LDB(B0, 1, 0); PG8_SCHED; PG8_LDA(At, 1, 0); PG8_STAGE(PG8_SA(0, 1), a2 + hstep, voffA);
            PG8_WAIT_L(8); PG8_BAR; PG8_WAIT_L(0); PG8_MMA(0, 0, At, B0); PG8_BAR; PG8_SCHED;
            PG8_LDB(B1, 1, 1); PG8_STAGE(PG8_SB(1, 0), b3, voffB);
            PG8_BAR; PG8_WAIT_L(0); PG8_MMA(0, 1, At, B1); PG8_BAR;
            PG8_LDA(At, 1, 1); PG8_STAGE(PG8_SA(1, 0), a3, voffA);
            PG8_BAR; PG8_WAIT_L(0); PG8_MMA(1, 0, At, B0); PG8_BAR; PG8_SCHED;
            PG8_STAGE(PG8_SB(1, 1), b3 + hstep, voffB);
            PG8_WAIT_V(6); PG8_BAR; PG8_MMA(1, 1, At, B1); PG8_BAR;
            }
        }
        if constexpr (ALIGN_EPI) { if (wr == 0) PG8_BAR; }
        if constexpr (!Epi::AFTER_DRAIN) { E(acc, cur, wr, wc, fr, fq); S.done(cur); }
        if (!has_next) break;
#pragma unroll
        for (int a = 0; a < 2; ++a)
#pragma unroll
            for (int b = 0; b < 2; ++b)
#pragma unroll
                for (int m = 0; m < 4; ++m)
#pragma unroll
                    for (int n = 0; n < 2; ++n) acc[a][b][m][n] = (f32x4){0.f, 0.f, 0.f, 0.f};
        cur = nxt; cA = nA; cB = nB; ++ui;
        if constexpr (ALIGN_EPI) { if (wr == 1) PG8_BAR; }
    }
    PG8_WAIT_V(0);
    if constexpr (!ALIGN_EPI) { if (wr == 0) PG8_BAR; }
    PG8_BAR;
    if constexpr (Epi::AFTER_DRAIN) { E.fused(acc, cur, wr, wc, fr, fq, lds, wid, lane); S.done(cur); }
#undef PG8_SA
#undef PG8_SB
#undef PG8_STAGE
#undef PG8_LDA
#undef PG8_LDB
#undef PG8_MMA
#undef PG8_WAIT_V
#undef PG8_WAIT_L
#undef PG8_BAR
#undef PG8_SCHED
}
}
#include <hip/hip_bf16.h>
#include <cmath>
namespace attn_body {
using bf16=__hip_bfloat16;
using bf16x8=__attribute__((ext_vector_type(8)))short;
using s16x4=__attribute__((ext_vector_type(4)))short;
using f32x16=__attribute__((ext_vector_type(16)))float;
using u32x4=__attribute__((ext_vector_type(4)))unsigned;
constexpr int BATCH=8,NHEAD=8,NKV=2,SEQ=4096,D=64,QP=512,KVP=256;
constexpr int NW=8,QBLK=32,QB=QBLK*NW,KVBLK=64,NQB=SEQ/QB;
constexpr int ATTN_UNIT_ROWS=QB;
__device__ __forceinline__ int crow(int r,int hi){return (r&3)+8*(r>>2)+4*hi;}
#define SBAR() __builtin_amdgcn_sched_barrier(0)
__device__ __forceinline__ void cmask(f32x16&p0,f32x16&p1,int jb,int qrel,int hi){
  const float NEG=-INFINITY; int kb=64*jb+4*hi;
  #pragma unroll
  for(int r=0;r<16;++r){int kv=kb+(r&3)+8*(r>>2); if(kv>qrel)p0[r]=NEG; if(kv+32>qrel)p1[r]=NEG;}
}

constexpr int NSLOT=3, SLOTB=8192;
constexpr int LDS_K=0, LDS_V=NSLOT*SLOTB, LDS_WS=2*NSLOT*SLOTB, LDS_OST=LDS_WS+NW*64*4, LDS_BYTES=LDS_OST+NW*4096;
constexpr float C2=0.125f*1.4426950408889634f;
__device__ __forceinline__ void glds16(const void*gsrc,unsigned lds_dst){unsigned keep;
  asm volatile("s_mov_b32 %0, m0\n\ts_mov_b32 m0, %2\n\ts_nop 0\n\tglobal_load_lds_dwordx4 %1, off\n\ts_mov_b32 m0, %0":"=&s"(keep):"v"(gsrc),"s"(lds_dst):"memory");}
__device__ __forceinline__ float max3f(float a,float b,float c){float r;asm("v_max3_f32 %0, %1, %2, %3":"=v"(r):"v"(a),"v"(b),"v"(c));return r;}
__device__ __forceinline__ float max2f(float a,float b){float r;asm("v_max_f32_e32 %0, %1, %2":"=v"(r):"v"(a),"v"(b));return r;}
__device__ __forceinline__ float fadd_s(float a,float b){float r;asm("v_add_f32_e32 %0, %1, %2":"=v"(r):"v"(a),"v"(b));return r;}
__device__ __forceinline__ float fsub_s(float a,float b){float r;asm("v_sub_f32_e32 %0, %1, %2":"=v"(r):"v"(a),"v"(b));return r;}
typedef float f32x2_t __attribute__((ext_vector_type(2))); typedef __bf16 bf16x2_t __attribute__((ext_vector_type(2)));
__device__ __forceinline__ unsigned cvtpk_s(float lo,float hi){f32x2_t v={lo,hi};bf16x2_t b=__builtin_convertvector(v,bf16x2_t);return __builtin_bit_cast(unsigned,b);}
#define WAIT_BAR(N) asm volatile("s_waitcnt vmcnt(" #N ") lgkmcnt(0)\n\ts_barrier":::"memory")

__device__ __forceinline__ void qkt(f32x16&p0,f32x16&p1,const char*Kslot,const bf16x8*qr,const f32x16&negm,int r32,int hi){
  const char*kb=Kslot+hi*1024+r32*16;
  #pragma unroll
  for(int d0=0;d0<4;++d0){
    const bf16x8 b0=*reinterpret_cast<const bf16x8*>(kb+d0*2048);
    const bf16x8 b1=*reinterpret_cast<const bf16x8*>(kb+d0*2048+512);
    if(d0==0){p0=__builtin_amdgcn_mfma_f32_32x32x16_bf16(b0,qr[0],negm,0,0,0);p1=__builtin_amdgcn_mfma_f32_32x32x16_bf16(b1,qr[0],negm,0,0,0);}
    else{p0=__builtin_amdgcn_mfma_f32_32x32x16_bf16(b0,qr[d0],p0,0,0,0);p1=__builtin_amdgcn_mfma_f32_32x32x16_bf16(b1,qr[d0],p1,0,0,0);}}
}
typedef __attribute__((address_space(3))) const char* lds_cptr;
typedef short v4i16_t __attribute__((ext_vector_type(4)));
__device__ __forceinline__ void kload8(bf16x8*kf,lds_cptr kp){
  kf[0]=*(const __attribute__((address_space(3))) bf16x8*)(kp);      kf[1]=*(const __attribute__((address_space(3))) bf16x8*)(kp+512);
  kf[2]=*(const __attribute__((address_space(3))) bf16x8*)(kp+2048); kf[3]=*(const __attribute__((address_space(3))) bf16x8*)(kp+2560);
  kf[4]=*(const __attribute__((address_space(3))) bf16x8*)(kp+4096); kf[5]=*(const __attribute__((address_space(3))) bf16x8*)(kp+4608);
  kf[6]=*(const __attribute__((address_space(3))) bf16x8*)(kp+6144); kf[7]=*(const __attribute__((address_space(3))) bf16x8*)(kp+6656);
}
__device__ __forceinline__ void kload2(bf16x8*kf,lds_cptr kp,int j){ kf[2*j]=*(const __attribute__((address_space(3))) bf16x8*)(kp+j*2048); kf[2*j+1]=*(const __attribute__((address_space(3))) bf16x8*)(kp+j*2048+512); }
__device__ __forceinline__ s16x4 vtr(lds_cptr p){ return __builtin_bit_cast(s16x4,__builtin_amdgcn_ds_read_tr16_b64_v4i16((__attribute__((address_space(3))) v4i16_t*)p)); }
__device__ __forceinline__ float rowmax(const f32x16&p0,const f32x16&p1){
  float a=max3f(p0[0],p0[1],p1[0]),b=max3f(p0[2],p0[3],p1[1]);a=max3f(a,p1[2],p1[3]);
  #pragma unroll
  for(int r=4;r<16;r+=4){a=max3f(a,p0[r],p0[r+1]);b=max3f(b,p0[r+2],p0[r+3]);a=max3f(a,p1[r],p1[r+1]);b=max3f(b,p1[r+2],p1[r+3]);}
  const float m=max2f(a,b);
  auto rr=__builtin_amdgcn_permlane32_swap(__float_as_uint(m),__float_as_uint(m),false,false);
  return max2f(__uint_as_float(rr[0]),__uint_as_float(rr[1]));
}
__device__ __forceinline__ void pv(f32x16*o,int vb,bf16x8 pa0,bf16x8 pa1,bf16x8 pa2,bf16x8 pa3){
  #pragma unroll
  for(int d0=0;d0<2;++d0){s16x4 lo[4],hi[4];
    #pragma unroll
    for(int ks=0;ks<4;++ks){
      asm volatile("ds_read_b64_tr_b16 %0,%1 offset:%c2":"=&v"(lo[ks]):"v"(vb),"i"(d0*4096+ks*1024):"memory");
      asm volatile("ds_read_b64_tr_b16 %0,%1 offset:%c2":"=&v"(hi[ks]):"v"(vb),"i"(d0*4096+ks*1024+512):"memory");}
    asm volatile("s_waitcnt lgkmcnt(0)":::"memory");SBAR();
    #define PK(k) (bf16x8){lo[k][0],lo[k][1],lo[k][2],lo[k][3],hi[k][0],hi[k][1],hi[k][2],hi[k][3]}
    o[d0]=__builtin_amdgcn_mfma_f32_32x32x16_bf16(pa0,PK(0),o[d0],0,0,0);
    o[d0]=__builtin_amdgcn_mfma_f32_32x32x16_bf16(pa1,PK(1),o[d0],0,0,0);
    o[d0]=__builtin_amdgcn_mfma_f32_32x32x16_bf16(pa2,PK(2),o[d0],0,0,0);
    o[d0]=__builtin_amdgcn_mfma_f32_32x32x16_bf16(pa3,PK(3),o[d0],0,0,0);
    #undef PK
  }
}

#ifndef ATTN_STORE16
#define ATTN_STORE16(p,v) (*(u32x4*)(p)=(v))
#endif
template<int THRL> __device__ __forceinline__ void attn_unit(int b,int h,int qb,const bf16*Q,const bf16*__restrict__ KV,const bf16*__restrict__ GA,bf16*O,char*shm){
  int tid_=threadIdx.x; asm volatile("":"+v"(tid_)); const int tid=tid_,lane=tid&63,r32=lane&31,hi=lane>>5; const int wid=__builtin_amdgcn_readfirstlane(tid>>6);
  const long rowbase=(long)b*SEQ; const int q0=qb*QB;
  const bf16*Qw=Q+(rowbase+q0+wid*QBLK)*QP+h*D;
  const int kvh=h>>2; const bf16*Kh=KV+rowbase*KVP+kvh*D,*Vh=KV+rowbase*KVP+128+kvh*D;
  const unsigned lds0=(unsigned)(uintptr_t)shm;
  float*wsf=(float*)(shm+LDS_WS)+wid*64;
  const bf16*ksrc=Kh+(long)lane*KVP+wid*8;
  const bf16*vsrc=Vh+(long)(16*(wid&3)+(lane>>2))*KVP+(wid>>2)*32+(lane&3)*8;
  const unsigned kdst=lds0+LDS_K+wid*1024, vdst=lds0+LDS_V+wid*1024;
  #define DMA_K(t,slot) glds16(ksrc+(long)(t)*KVBLK*KVP,(unsigned)__builtin_amdgcn_readfirstlane(kdst+(slot)))
  #define DMA_V(t,slot) glds16(vsrc+(long)(t)*KVBLK*KVP,(unsigned)__builtin_amdgcn_readfirstlane(vdst+(slot)))
  const int vb0=(int)(lds0+LDS_V)+((lane>>4)&1)*32+(lane&3)*8+(4*hi+((lane&15)>>2))*64;
  const char*Kbase=shm+LDS_K; bf16x8 kf[8];
  const lds_cptr shm3=(lds_cptr)shm; const lds_cptr kp0=shm3+LDS_K+hi*1024+r32*16; const lds_cptr vp0=shm3+LDS_V+((lane>>4)&1)*32+(lane&3)*8+(4*hi+((lane&15)>>2))*64;
  const int NT=SEQ/KVBLK;
  DMA_K(0,0);DMA_V(0,0);DMA_K(1,SLOTB);
  bf16x8 qr[4];
  #pragma unroll
  for(int d0=0;d0<4;++d0)qr[d0]=*reinterpret_cast<const bf16x8*>(&Qw[(long)r32*QP+d0*16+hi*8]);
  float mhat=0.f,l_reg=0.f;f32x16 o[2];o[0]=f32x16{};o[1]=f32x16{};f32x16 negm=f32x16{};asm volatile("":"+v"(negm));
  #define CMASK(P0,P1,t) do{}while(0)
  bool resc=false;
  #define START(P0,P1) do{ const float rm=rowmax(P0,P1); resc=false; \
    { const float dl=rm; mhat=fadd_s(mhat,dl); \
      _Pragma("unroll") for(int r=0;r<16;++r){P0[r]=fsub_s(P0[r],dl);P1[r]=fsub_s(P1[r],dl);} \
      _Pragma("unroll") for(int r=0;r<16;++r)negm[r]=-mhat; asm volatile("":"+v"(negm)); } \
    _Pragma("unroll") for(int r=0;r<16;++r)P0[r]=__builtin_amdgcn_exp2f(P0[r]); }while(0)
  #define RESC() do{ if(resc){ asm volatile("s_waitcnt lgkmcnt(0)":::"memory"); \
      _Pragma("unroll") for(int d_=0;d_<2;++d_) _Pragma("unroll") for(int r=0;r<16;++r)o[d_][r]*=wsf[crow(r,hi)]; } }while(0)
  f32x16 pA0,pA1,pB0,pB1;
  int sl_prev=0,sl_cur=0,sl_next=SLOTB;
  #define ROT() do{sl_prev=sl_cur;sl_cur=sl_next;sl_next=(sl_next==(NSLOT-1)*SLOTB)?0:sl_next+SLOTB;}while(0)
  DMA_K(2,2*SLOTB);
  WAIT_BAR(3);
  qkt(pA0,pA1,Kbase,qr,negm,r32,hi);asm volatile("s_nop 15\n\ts_nop 7":"+v"(pA0),"+v"(pA1));CMASK(pA0,pA1,0);
  START(pA0,pA1);
  _Pragma("unroll") for(int r=0;r<16;++r)pA1[r]=__builtin_amdgcn_exp2f(pA1[r]);
  WAIT_BAR(0);
  DMA_K(3,0);DMA_V(1,SLOTB);
  ROT();
  kload8(kf,kp0+sl_cur);
  WAIT_BAR(2);
  s16x4 vlo[8],vhi[8]; u32x4 pw0,pw1,pw2,pw3;
  #define PKW(P,B) cvtpk_s(P[B],P[B+1])
  #define PAF(k) __builtin_bit_cast(bf16x8,pw##k)
  #define VFR(i) (bf16x8){vlo[i][0],vlo[i][1],vlo[i][2],vlo[i][3],vhi[i][0],vhi[i][1],vhi[i][2],vhi[i][3]}
  #define PIN(x) asm volatile("":"+v"(x))
  #define MX3(a,b,c) __builtin_fmaxf(__builtin_fmaxf((a),(b)),(c))
  #define GAPA(MF,A0,A1,A2,A3,W0,W1,PW) do{ MF; sacc+=A0; sacc+=A1; sacc+=A2; sacc+=A3; PIN(sacc); W0; W1; PIN(PW); SBAR(); }while(0)
  #define EX(v) __builtin_amdgcn_exp2f(v)
  #define GAPB(MF,X,B) do{ MF; X[B]=EX(X[B]); X[B+1]=EX(X[B+1]); X[B+2]=EX(X[B+2]); X[B+3]=EX(X[B+3]); PIN(X); SBAR(); }while(0)
  #define VRD(i) do{ vlo[i]=vtr(vp_+(((i)>>2)*4096+((i)&3)*1024)); vhi[i]=vtr(vp_+(((i)>>2)*4096+((i)&3)*1024+512)); }while(0)
  #define KRD(G,j) do{ if(G){ kload2(kf,kp0+sl_next,j); SBAR(); } }while(0)
  #define STEP(C0,C1,P0,P1,t,GK,GV,GL) do{ SBAR(); \
    const lds_cptr vp_=vp0+sl_prev; \
    VRD(0); SBAR(); float sacc=(P0[0]+P0[1]); \
    GAPA(C0=__builtin_amdgcn_mfma_f32_32x32x16_bf16(kf[0],qr[0],negm,0,0,0), P0[2],P0[3],P0[4],P0[5],     pw0[0]=PKW(P0,0), pw0[1]=PKW(P0,2), pw0); \
    VRD(4); SBAR(); GAPA(C1=__builtin_amdgcn_mfma_f32_32x32x16_bf16(kf[1],qr[0],negm,0,0,0), P0[6],P0[7],P0[8],P0[9],     pw0[2]=PKW(P0,4), pw0[3]=PKW(P0,6), pw0); \
    VRD(1); SBAR(); GAPA(C0=__builtin_amdgcn_mfma_f32_32x32x16_bf16(kf[2],qr[1],C0,0,0,0),   P0[10],P0[11],P0[12],P0[13], pw1[0]=PKW(P0,8), pw1[1]=PKW(P0,10), pw1); \
    VRD(5); SBAR(); GAPA(C1=__builtin_amdgcn_mfma_f32_32x32x16_bf16(kf[3],qr[1],C1,0,0,0),   P0[14],P0[15],P1[0],P1[1],   pw1[2]=PKW(P0,12),pw1[3]=PKW(P0,14), pw1); \
    VRD(2); SBAR(); GAPA(C0=__builtin_amdgcn_mfma_f32_32x32x16_bf16(kf[4],qr[2],C0,0,0,0),   P1[2],P1[3],P1[4],P1[5],     pw2[0]=PKW(P1,0), pw2[1]=PKW(P1,2), pw2); \
    VRD(6); SBAR(); GAPA(C1=__builtin_amdgcn_mfma_f32_32x32x16_bf16(kf[5],qr[2],C1,0,0,0),   P1[6],P1[7],P1[8],P1[9],     pw2[2]=PKW(P1,4), pw2[3]=PKW(P1,6), pw2); \
    VRD(3); SBAR(); GAPA(C0=__builtin_amdgcn_mfma_f32_32x32x16_bf16(kf[6],qr[3],C0,0,0,0),   P1[10],P1[11],P1[12],P1[13], pw3[0]=PKW(P1,8), pw3[1]=PKW(P1,10), pw3); \
    VRD(7); SBAR(); GAPA(C1=__builtin_amdgcn_mfma_f32_32x32x16_bf16(kf[7],qr[3],C1,0,0,0),   P1[14],P1[15],0.f,0.f,       pw3[2]=PKW(P1,12),pw3[3]=PKW(P1,14), pw3); \
    l_reg+=sacc; \
    if(GK){DMA_K((t)+3,sl_cur);} if(GV){DMA_V((t)+1,sl_next);} \
    CMASK(C0,C1,t); \
    { float a=MX3(C0[0],C0[1],C1[0]),b=MX3(C0[2],C0[3],C1[1]); a=MX3(a,C1[2],C1[3]); \
      _Pragma("unroll") for(int r=4;r<16;r+=4){a=MX3(a,C0[r],C0[r+1]);b=MX3(b,C0[r+2],C0[r+3]);a=MX3(a,C1[r],C1[r+1]);b=MX3(b,C1[r+2],C1[r+3]);} \
      float rm=__builtin_fmaxf(a,b); { auto rr=__builtin_amdgcn_permlane32_swap(__float_as_uint(rm),__float_as_uint(rm),false,false); rm=__builtin_fmaxf(__uint_as_float(rr[0]),__uint_as_float(rr[1])); } \
      resc=false; \
      if(__builtin_expect(__any(rm>(float)THRL),0)){ const float dl=__builtin_fmaxf(rm,0.f); mhat+=dl; \
        _Pragma("unroll") for(int r=0;r<16;++r){C0[r]-=dl;C1[r]-=dl;} \
        _Pragma("unroll") for(int r=0;r<16;++r)negm[r]=-mhat; asm volatile("":"+v"(negm)); \
        const float f=__builtin_amdgcn_exp2f(-dl); l_reg*=f; if(hi==0)wsf[r32]=f; resc=true; } } \
    SBAR(); \
    GAPB(o[0]=__builtin_amdgcn_mfma_f32_32x32x16_bf16(PAF(0),VFR(0),o[0],0,0,0), C0,0); \
    GAPB(o[1]=__builtin_amdgcn_mfma_f32_32x32x16_bf16(PAF(0),VFR(4),o[1],0,0,0), C0,4); \
    KRD(GL,0); GAPB(o[0]=__builtin_amdgcn_mfma_f32_32x32x16_bf16(PAF(1),VFR(1),o[0],0,0,0), C0,8); \
    KRD(GL,1); GAPB(o[1]=__builtin_amdgcn_mfma_f32_32x32x16_bf16(PAF(1),VFR(5),o[1],0,0,0), C0,12); \
    KRD(GL,2); GAPB(o[0]=__builtin_amdgcn_mfma_f32_32x32x16_bf16(PAF(2),VFR(2),o[0],0,0,0), C1,0); \
    KRD(GL,3); GAPB(o[1]=__builtin_amdgcn_mfma_f32_32x32x16_bf16(PAF(2),VFR(6),o[1],0,0,0), C1,4); \
    GAPB(o[0]=__builtin_amdgcn_mfma_f32_32x32x16_bf16(PAF(3),VFR(3),o[0],0,0,0), C1,8); \
    GAPB(o[1]=__builtin_amdgcn_mfma_f32_32x32x16_bf16(PAF(3),VFR(7),o[1],0,0,0), C1,12); \
    }while(0)
  int t=1;
  #undef CMASK
  #define CMASK(P0,P1,t) do{}while(0)
  for(;t+5<NT;t+=2){
    STEP(pB0,pB1,pA0,pA1,t,true,true,true);     WAIT_BAR(2); RESC(); ROT();
    STEP(pA0,pA1,pB0,pB1,t+1,true,true,true);   WAIT_BAR(2); RESC(); ROT();
  }
  #undef CMASK
  #define CMASK(P0,P1,t) do{}while(0)
  #define ENDW(tt) do{ if((tt)+3<NT){WAIT_BAR(2);} else if((tt)+2<NT){WAIT_BAR(1);} else {WAIT_BAR(0);} }while(0)
  for(;t+1<NT;t+=2){
    STEP(pB0,pB1,pA0,pA1,t,(t+3<NT),(t+1<NT),(t+1<NT));       ENDW(t);   RESC(); ROT();
    STEP(pA0,pA1,pB0,pB1,t+1,(t+4<NT),(t+2<NT),(t+2<NT));     ENDW(t+1); RESC(); ROT();
  }
  STEP(pB0,pB1,pA0,pA1,NT-1,false,false,false); RESC();
  { float sacc=pB0[0]+pB0[1]; _Pragma("unroll") for(int r=2;r<16;++r)sacc+=pB0[r]; _Pragma("unroll") for(int r=0;r<16;++r)sacc+=pB1[r]; l_reg+=sacc;
    pw0=(u32x4){PKW(pB0,0),PKW(pB0,2),PKW(pB0,4),PKW(pB0,6)};pw1=(u32x4){PKW(pB0,8),PKW(pB0,10),PKW(pB0,12),PKW(pB0,14)};pw2=(u32x4){PKW(pB1,0),PKW(pB1,2),PKW(pB1,4),PKW(pB1,6)};pw3=(u32x4){PKW(pB1,8),PKW(pB1,10),PKW(pB1,12),PKW(pB1,14)};
    SBAR(); pv(o,vb0+sl_cur,PAF(0),PAF(1),PAF(2),PAF(3)); }
  #undef PKW
  #undef PAF
  #undef VFR
  #undef PIN
  #undef MX3
  #undef GAPA
  #undef GAPB
  #undef EX
  #undef VRD
  #undef KRD
  #undef STEP
  #undef ENDW
  {auto rr=__builtin_amdgcn_permlane32_swap(__float_as_uint(l_reg),__float_as_uint(l_reg),false,false);l_reg=__uint_as_float(rr[0])+__uint_as_float(rr[1]);}
  if(hi==0)wsf[32+r32]=l_reg;asm volatile("s_waitcnt lgkmcnt(0)":::"memory");
  float rli[16];
  #pragma unroll
  for(int r=0;r<16;++r)rli[r]=__builtin_amdgcn_rcpf(wsf[32+crow(r,hi)]);
  bf16*Ow=O+(rowbase+q0+wid*QBLK)*QP+h*D; const bf16*Gw=GA+(rowbase+q0+wid*QBLK)*QP+h*D;
  { bf16*stg=(bf16*)(shm+LDS_OST)+wid*2048;
    #pragma unroll
    for(int r=0;r<16;++r){const int orow=crow(r,hi);
      #pragma unroll
      for(int d0=0;d0<2;++d0)stg[orow*64+d0*32+r32]=__float2bfloat16(o[d0][r]*rli[r]*__bfloat162float(Gw[(long)orow*QP+d0*32+r32]));}
    asm volatile("s_waitcnt lgkmcnt(0)":::"memory");
    #pragma unroll
    for(int i=0;i<4;++i){const int row=i*8+(lane>>3),ch=lane&7; const u32x4 v=*(const u32x4*)(stg+row*64+ch*8); ATTN_STORE16(Ow+(long)row*QP+ch*8,v);} }
  asm volatile("s_waitcnt lgkmcnt(0)\n\ts_barrier":::"memory");
  #undef DMA_K
  #undef DMA_V
  #undef CMASK
  #undef START
  #undef RESC
  #undef ROT
}
constexpr int ATTN_LDS_BYTES=LDS_BYTES;
struct AttnTensors { const bf16* Q; const bf16* KV; const bf16* GA; bf16* O; };
struct AttnUnit { int bh; int qb; };
struct StaticOrder {
  int vcu, grid;
  __device__ __forceinline__ explicit StaticOrder(int grid_,int block):vcu((grid_%8==0)?(block%8)*(grid_/8)+block/8:block),grid(grid_){}
  __device__ __forceinline__ bool next(int i,AttnUnit&u)const{
    int U; if(grid==256){ if(i>=4)return false; U=vcu*4+i; } else { U=i*grid+vcu; if(U>=BATCH*NHEAD*NQB)return false; }
    const int b=U>>7,idx=U&127; u.bh=b*NHEAD+(idx>>4); u.qb=idx&15; return true; }
  __device__ __forceinline__ void a_ready(const AttnUnit&)const{}
  __device__ __forceinline__ void done(const AttnUnit&)const{}
};
template<class Sched,int THRL=8> __device__ __forceinline__ void attn_phase(char*lds,const AttnTensors&T,const Sched&S){
  AttnUnit u;
  for(int i=0;S.next(i,u);++i){ S.a_ready(u); attn_unit<THRL>(u.bh/NHEAD,u.bh%NHEAD,u.qb,T.Q,T.KV,T.GA,T.O,lds); S.done(u); }
}
#undef SBAR
#undef WAIT_BAR
}

constexpr int NWAVES = 8;
constexpr int RING_OFF = 0, RING_BYTES = 131072, TAB_OFF = RING_BYTES, TAB_BYTES = 6144 * 4, LDSCTL_OFF = TAB_OFF + TAB_BYTES, MISC_OFF = LDSCTL_OFF + 320;
constexpr int LDS_BYTES = LDSCTL_OFF + 512;
static_assert(LDS_BYTES <= 160 * 1024, "LDS");
constexpr int CW_TMO = 0, CW_CODE = 1, CW_BAR = 4096;

#define GAS __attribute__((address_space(1)))
#define LAS __attribute__((address_space(3)))
typedef unsigned v4u __attribute__((ext_vector_type(4)));
typedef float f32x4 __attribute__((ext_vector_type(4)));
typedef GAS unsigned gu32;
#define RLX_AGENT __ATOMIC_RELAXED, __HIP_MEMORY_SCOPE_AGENT
#define LDS_WAIT() asm volatile("s_waitcnt lgkmcnt(0)" ::: "memory")
#define VM_WAIT() asm volatile("s_waitcnt vmcnt(0)" ::: "memory")
__device__ __forceinline__ unsigned pk2(float lo, float hi) { return f2bf(lo) | (f2bf(hi) << 16); }

#define XB_TMO      128
#define XB_XCNT(j)  (256  + 64 * (j))
#define XB_XSUB(j)  (1280 + 64 * (j))
#define XB_XGEN(j)  (2304 + 64 * (j))
#define XB_TOP      3328
#define XB_TOPGEN   3392
#define XCD_BAR_WORDS 3456
#define XB_SPIN_CAP (1u << 18)

__device__ __forceinline__ unsigned xb_ld(unsigned* p)              { return __hip_atomic_load(p, __ATOMIC_RELAXED, __HIP_MEMORY_SCOPE_AGENT); }
__device__ __forceinline__ unsigned xb_add(unsigned* p, unsigned v) { return __hip_atomic_fetch_add(p, v, __ATOMIC_RELAXED, __HIP_MEMORY_SCOPE_AGENT); }
__device__ __forceinline__ unsigned xb_xcc_id() { return (unsigned)__builtin_amdgcn_s_getreg((3 << 11) | 20) & 0xFu; }
#define XB_SPIN(cond, bar) do { unsigned _sp = 0; while (cond) { __builtin_amdgcn_s_sleep(1); \
    if ((++_sp & 255u) == 0u) { if (xb_ld(&(bar)[XB_TMO])) break; if (_sp > XB_SPIN_CAP) { atomicAdd(&(bar)[XB_TMO], 1u); break; } } } } while (0)

struct XcdBarrier {
    unsigned* bar; unsigned x;
    volatile LAS unsigned* st;
};

__device__ __forceinline__ XcdBarrier xcd_barrier_post(unsigned* bar, volatile LAS unsigned* st) {
    XcdBarrier b; b.bar = bar; b.x = xb_xcc_id(); b.st = st;
    if (threadIdx.x == 0) (void)xb_add(&bar[XB_XCNT(b.x)], 1u);
    return b;
}
__device__ __forceinline__ void xcd_barrier_complete(unsigned* bar, unsigned x, unsigned& nloc, unsigned& nx) {
    const unsigned G = gridDim.x * gridDim.y * gridDim.z;
    unsigned sum, cnt, mine, sp = 0u;
    for (;;) {
        sum = 0u; cnt = 0u; mine = 0u;
#pragma unroll
        for (unsigned j = 0; j < 16; ++j) { const unsigned c = xb_ld(&bar[XB_XCNT(j)]); sum += c; cnt += (c > 0u) ? 1u : 0u; mine = (j == x) ? c : mine; }
        if (sum == G) break;
        __builtin_amdgcn_s_sleep(1);
        if ((++sp & 255u) == 0u) { if (xb_ld(&bar[XB_TMO])) break; if (sp > XB_SPIN_CAP) { atomicAdd(&bar[XB_TMO], 1u); break; } }
    }
    nloc = mine > 0u ? mine : 1u; nx = cnt > 0u ? cnt : 1u;
}

__device__ __forceinline__ void xcd_barrier(const XcdBarrier& b) {
    asm volatile("s_waitcnt vmcnt(0)" ::: "memory");
    __syncthreads();
    if (threadIdx.x == 0) {
        unsigned* bar = b.bar;
        __builtin_amdgcn_s_waitcnt(0);
        unsigned nloc = b.st[0], nx = b.st[1];
        if (nloc == 0u) { xcd_barrier_complete(bar, b.x, nloc, nx); b.st[0] = nloc; b.st[1] = nx; }
        const unsigned old = xb_add(&bar[XB_XSUB(b.x)], 1u);
        const unsigned gen = old / nloc;
        if (old + 1u == (gen + 1u) * nloc) {
            __builtin_amdgcn_fence(__ATOMIC_RELEASE, "agent");
            asm volatile("s_waitcnt vmcnt(0)" ::: "memory");
            const unsigned og = xb_add(&bar[XB_TOP], 1u);
            const unsigned tg = og / nx;
            if (og + 1u == (tg + 1u) * nx) xb_add(&bar[XB_TOPGEN], 1u);
            else XB_SPIN(xb_ld(&bar[XB_TOPGEN]) == tg, bar);
            __builtin_amdgcn_fence(__ATOMIC_ACQUIRE, "agent");
            xb_add(&bar[XB_XGEN(b.x)], 1u);
            asm volatile("s_waitcnt vmcnt(0)" ::: "memory");
        } else {
            XB_SPIN(xb_ld(&bar[XB_XGEN(b.x)]) == gen, bar);
            __builtin_amdgcn_fence(__ATOMIC_ACQUIRE, "agent");
            asm volatile("s_waitcnt vmcnt(0)" ::: "memory");
        }
    }
    __syncthreads();
}
namespace ret_body {
typedef short bf16x8 __attribute__((ext_vector_type(8)));
typedef short s16x4 __attribute__((ext_vector_type(4)));
typedef short v4i16_t __attribute__((ext_vector_type(4)));
typedef float f32x16 __attribute__((ext_vector_type(16)));
typedef float f32x4 __attribute__((ext_vector_type(4)));
typedef unsigned u32x4 __attribute__((ext_vector_type(4)));
#define RLAS __attribute__((address_space(3)))
constexpr int RS = 272;
constexpr int OS = 132;
constexpr int REG1 = 128 * RS;
__device__ __forceinline__ int crow(int g, int hi) { return (g & 3) + 8 * (g >> 2) + 4 * hi; }
__device__ __forceinline__ s16x4 vtr(const RLAS unsigned char* p) { return __builtin_bit_cast(s16x4, __builtin_amdgcn_ds_read_tr16_b64_v4i16((RLAS v4i16_t*)p)); }
__device__ __forceinline__ unsigned pkbf(float lo, float hi) { unsigned r; asm volatile("v_cvt_pk_bf16_f32 %0, %1, %2" : "=v"(r) : "v"(lo), "v"(hi)); return r; }
#define RMFMA(a, b, c) __builtin_amdgcn_mfma_f32_32x32x16_bf16(a, b, c, 0, 0, 0)
__device__ __forceinline__ bf16x8 trfrag(const RLAS unsigned char* base, int row_lo, int row_hi_off, int colbyte) {
    const s16x4 lo = vtr(base + row_lo * RS + colbyte), hi = vtr(base + (row_lo + row_hi_off) * RS + colbyte);
    return (bf16x8){lo[0], lo[1], lo[2], lo[3], hi[0], hi[1], hi[2], hi[3]};
}

struct ScanRegs { u32x4 k[4]; u32x4 v; };
__device__ __forceinline__ void scan_load(ScanRegs& R, const bf16_t* KR, const bf16_t* VR, size_t tok0, int h, int e, int tid) {
    const int row = tid >> 2, qt = tid & 3;
    const bf16_t* kp = KR + (tok0 + row) * 512 + h * 128 + qt * 32;
#pragma unroll
    for (int i = 0; i < 4; ++i) R.k[i] = *(const u32x4*)(kp + 8 * i);
    R.v = *(const u32x4*)(VR + (tok0 + row) * 512 + h * 128 + e * 32 + qt * 8);
}
__device__ __forceinline__ void scan_unit(RLAS unsigned char* L, int b, int h, int dir, int e, const bf16_t* KR, const bf16_t* VR, bf16_t* ST, float lg) {
    int tid_ = threadIdx.x; asm volatile("" : "+v"(tid_));
    const int tid = tid_, lane = tid & 63, w = __builtin_amdgcn_readfirstlane(tid >> 6), r = lane & 31, h2 = lane >> 5;
    RLAS unsigned char* Ks = L; RLAS unsigned char* Vt = L + REG1;
    const int srow = tid >> 2, sqt = tid & 3;
    const float wgt = __builtin_amdgcn_exp2f(lg * (float)(dir ? srow : 127 - srow));
    const float cdec = __builtin_amdgcn_exp2f(lg * 128.f);
    f32x16 acc;
#pragma unroll
    for (int g = 0; g < 16; ++g) acc[g] = 0.f;
    bf16_t* stb = ST + ((size_t)((dir * 8 + b) * 4 + h) * 32) * 16384 + (size_t)(32 * e) * 128 + 32 * w + r;
    const size_t tokb = (size_t)b * SEQ;
    const int q = (lane & 15) >> 2, p = lane & 3, gq = (lane >> 4) & 1;
    ScanRegs RA, RB;
    scan_load(RA, KR, VR, tokb + (size_t)(dir ? 31 : 0) * 128, h, e, tid);
    scan_load(RB, KR, VR, tokb + (size_t)(dir ? 30 : 1) * 128, h, e, tid);
#define SCAN_STEP(R, s) do { \
        const int c_ = dir ? 31 - (s) : (s); \
        __syncthreads();                                                         \
        { RLAS unsigned char* kd = Ks + srow * RS + sqt * 64; \
          _Pragma("unroll") for (int i = 0; i < 4; ++i) *(RLAS u32x4*)(kd + 16 * i) = R.k[i]; \
          const unsigned vv[4] = {R.v.x, R.v.y, R.v.z, R.v.w}; \
          _Pragma("unroll") for (int i = 0; i < 4; ++i) { \
              const float f0 = __uint_as_float(vv[i] << 16) * wgt, f1 = __uint_as_float(vv[i] & 0xffff0000u) * wgt; const unsigned pk = pkbf(f0, f1); \
              *(RLAS unsigned short*)(Vt + (sqt * 8 + 2 * i) * RS + srow * 2) = (unsigned short)(pk & 0xffffu); \
              *(RLAS unsigned short*)(Vt + (sqt * 8 + 2 * i + 1) * RS + srow * 2) = (unsigned short)(pk >> 16); } } \
        if ((s) + 2 < 32) scan_load(R, KR, VR, tokb + (size_t)(dir ? 31 - ((s) + 2) : (s) + 2) * 128, h, e, tid); \
        if (w < 4) { bf16_t* sp = stb + (size_t)c_ * 16384; \
            _Pragma("unroll") for (int g = 0; g < 16; ++g) sp[crow(g, h2) * 128] = (bf16_t)(pkbf(acc[g], 0.f) & 0xffffu); } \
        __syncthreads(); \
        if (w < 4) { \
            _Pragma("unroll") for (int g = 0; g < 16; ++g) acc[g] *= cdec; \
            _Pragma("unroll") for (int ks = 0; ks < 8; ++ks) { \
                const bf16x8 a = *(const RLAS bf16x8*)(Vt + r * RS + (16 * ks + 8 * h2) * 2); \
                const bf16x8 bfr = trfrag(Ks, 16 * ks + 8 * h2 + q, 4, (32 * w + 16 * gq + 4 * p) * 2); \
                acc = RMFMA(a, bfr, acc); } } \
    } while (0)
    for (int s = 0; s < 32; s += 2) { SCAN_STEP(RA, s); SCAN_STEP(RB, s + 1); }
#undef SCAN_STEP
    __syncthreads();
}

__device__ __forceinline__ void out_unit(RLAS unsigned char* L, int b, int h, int c, bf16_t* QR, const bf16_t* KR, const bf16_t* VR, const bf16_t* GR, const bf16_t* ST, const float* gnw, float lgf, float lgb) {
    int tid_ = threadIdx.x; asm volatile("" : "+v"(tid_));
    const int tid = tid_, lane = tid & 63, w = __builtin_amdgcn_readfirstlane(tid >> 6), r = lane & 31, h2 = lane >> 5;
    const int ib = w >> 1, dvh = w & 1;
    const int q = (lane & 15) >> 2, p = lane & 3, gq = (lane >> 4) & 1;
    RLAS unsigned char* R0 = L; RLAS unsigned char* R1 = L + REG1;
    const size_t tok0 = (size_t)b * SEQ + (size_t)c * 128;
    const int srow = tid >> 2, sqt = tid & 3;
    { u32x4 kr[4], vr[4];
      const bf16_t* kp = KR + (tok0 + srow) * 512 + h * 128 + sqt * 32; const bf16_t* vp = VR + (tok0 + srow) * 512 + h * 128 + sqt * 32;
#pragma unroll
      for (int i = 0; i < 4; ++i) { kr[i] = *(const u32x4*)(kp + 8 * i); vr[i] = *(const u32x4*)(vp + 8 * i); }
#pragma unroll
      for (int i = 0; i < 4; ++i) { *(RLAS u32x4*)(R0 + srow * RS + sqt * 64 + 16 * i) = kr[i]; *(RLAS u32x4*)(R1 + srow * RS + sqt * 64 + 16 * i) = vr[i]; } }
    bf16x8 qf[8];
    { const bf16_t* qp = QR + (tok0 + 32 * ib + r) * 512 + h * 128 + 8 * h2;
#pragma unroll
      for (int ks = 0; ks < 8; ++ks) qf[ks] = *(const bf16x8*)(qp + 16 * ks); }
    u32x4 sfr[4], sbr[4];
    { const bf16_t* sf = ST + ((size_t)((0 * 8 + b) * 4 + h) * 32 + c) * 16384 + (size_t)srow * 128 + sqt * 32;
      const bf16_t* sb = ST + ((size_t)((1 * 8 + b) * 4 + h) * 32 + c) * 16384 + (size_t)srow * 128 + sqt * 32;
#pragma unroll
      for (int i = 0; i < 4; ++i) { sfr[i] = *(const u32x4*)(sf + 8 * i); sbr[i] = *(const u32x4*)(sb + 8 * i); } }
    __syncthreads();
    bf16x8 P[4][2];
    const int iq = 32 * ib + r;
#pragma unroll
    for (int jb = 0; jb < 4; ++jb) {
        f32x16 X;
#pragma unroll
        for (int g = 0; g < 16; ++g) X[g] = 0.f;
#pragma unroll
        for (int ks = 0; ks < 8; ++ks) { const bf16x8 a = *(const RLAS bf16x8*)(R0 + (32 * jb + r) * RS + (16 * ks + 8 * h2) * 2); X = RMFMA(a, qf[ks], X); }
#pragma unroll
        for (int g = 0; g < 16; ++g) { const int d = iq - (32 * jb + crow(g, h2)); X[g] *= __builtin_amdgcn_exp2f(d >= 0 ? (float)d * lgf : (float)(-d) * lgb); }
#pragma unroll
        for (int s = 0; s < 2; ++s) { u32x4 pw; pw.x = pkbf(X[8 * s + 0], X[8 * s + 1]); pw.y = pkbf(X[8 * s + 2], X[8 * s + 3]); pw.z = pkbf(X[8 * s + 4], X[8 * s + 5]); pw.w = pkbf(X[8 * s + 6], X[8 * s + 7]);
            P[jb][s] = __builtin_bit_cast(bf16x8, pw); }
    }
    f32x16 Z[2];
#pragma unroll
    for (int t = 0; t < 2; ++t) {
#pragma unroll
        for (int g = 0; g < 16; ++g) Z[t][g] = 0.f;
        const int cb = (64 * dvh + 32 * t + 16 * gq + 4 * p) * 2;
#pragma unroll
        for (int jb = 0; jb < 4; ++jb)
#pragma unroll
            for (int s = 0; s < 2; ++s) { const bf16x8 vf = trfrag(R1, 32 * jb + 16 * s + 4 * h2 + q, 8, cb); Z[t] = RMFMA(P[jb][s], vf, Z[t]); }
    }
    __syncthreads();
#pragma unroll
    for (int i = 0; i < 4; ++i) { *(RLAS u32x4*)(R0 + srow * RS + sqt * 64 + 16 * i) = sfr[i]; *(RLAS u32x4*)(R1 + srow * RS + sqt * 64 + 16 * i) = sbr[i]; }
    __syncthreads();
#pragma unroll
    for (int t = 0; t < 2; ++t) {
        f32x16 Yf, Yb;
#pragma unroll
        for (int g = 0; g < 16; ++g) { Yf[g] = 0.f; Yb[g] = 0.f; }
        const int rb = (64 * dvh + 32 * t + r) * RS + 16 * h2;
#pragma unroll
        for (int ks = 0; ks < 8; ++ks) { const bf16x8 bf_ = *(const RLAS bf16x8*)(R0 + rb + 32 * ks), bb_ = *(const RLAS bf16x8*)(R1 + rb + 32 * ks);
            Yf = RMFMA(qf[ks], bf_, Yf); Yb = RMFMA(qf[ks], bb_, Yb); }
#pragma unroll
        for (int g = 0; g < 16; ++g) { const int il = 32 * ib + crow(g, h2);
            Z[t][g] += __builtin_amdgcn_exp2f(lgf * (float)(il + 1)) * Yf[g] + __builtin_amdgcn_exp2f(lgb * (float)(128 - il)) * Yb[g]; }
    }
    __syncthreads();
    { RLAS float* Os = (RLAS float*)L;
#pragma unroll
      for (int t = 0; t < 2; ++t)
#pragma unroll
          for (int g = 0; g < 16; ++g) Os[(32 * ib + crow(g, h2)) * OS + 64 * dvh + 32 * t + r] = Z[t][g]; }
    __syncthreads();
    { const RLAS float* Os = (const RLAS float*)L + srow * OS + sqt * 32;
      f32x4 o[8]; float sm = 0.f;
#pragma unroll
      for (int i = 0; i < 8; ++i) { o[i] = *(const RLAS f32x4*)(Os + 4 * i); sm += (o[i][0] + o[i][1]) + (o[i][2] + o[i][3]); }
      sm += __shfl_xor(sm, 1); sm += __shfl_xor(sm, 2);
      const float mean = sm * (1.f / 128.f); float vq = 0.f;
#pragma unroll
      for (int i = 0; i < 8; ++i) { o[i] = o[i] - mean; vq += (o[i][0] * o[i][0] + o[i][1] * o[i][1]) + (o[i][2] * o[i][2] + o[i][3] * o[i][3]); }
      vq += __shfl_xor(vq, 1); vq += __shfl_xor(vq, 2);
      const float rstd = rsqrtf(vq * (1.f / 128.f) + EPS);
      const int cb = h * 128 + sqt * 32; const bf16_t* gp = GR + (tok0 + srow) * 512 + cb; bf16_t* op = QR + (tok0 + srow) * 512 + cb; const float* wp = gnw + cb;
#pragma unroll
      for (int i = 0; i < 4; ++i) { const u32x4 gw = *(const u32x4*)(gp + 8 * i); const f32x4 w0 = *(const f32x4*)(wp + 8 * i), w1 = *(const f32x4*)(wp + 8 * i + 4);
          const f32x4 a0 = o[2 * i] * rstd * w0, a1 = o[2 * i + 1] * rstd * w1; u32x4 ow;
          ow.x = pkbf(a0[0] * __uint_as_float(gw.x << 16), a0[1] * __uint_as_float(gw.x & 0xffff0000u)); ow.y = pkbf(a0[2] * __uint_as_float(gw.y << 16), a0[3] * __uint_as_float(gw.y & 0xffff0000u));
          ow.z = pkbf(a1[0] * __uint_as_float(gw.z << 16), a1[1] * __uint_as_float(gw.z & 0xffff0000u)); ow.w = pkbf(a1[2] * __uint_as_float(gw.w << 16), a1[3] * __uint_as_float(gw.w & 0xffff0000u));
          *(u32x4*)(op + 8 * i) = ow; } }
    __syncthreads();
}
#undef RMFMA
}


__device__ __forceinline__ bool inproj_rope_col(int c) { return c < 640 || (c >= 1280 && c < 2304); }
__device__ __forceinline__ void p0_transpose_item(const float* W, int K, int N, bf16_t* WT, LAS float* scr, int item, int lane, int permmode) {
    const int nblk = N / 32, kb = item / nblk, vb = item % nblk, k0 = 64 * kb;
    const int rb = (vb & ~7) + 2 * (vb & 3) + ((vb >> 2) & 1), n0 = 32 * rb;
    const bool perm = permmode == 1 || (permmode == 2 && !inproj_rope_col(n0));
#pragma unroll 8
    for (int i = 0; i < 32; ++i) { const int kk = 2 * i + (lane >> 5); scr[kk * 33 + (lane & 31)] = W[(size_t)(k0 + kk) * N + n0 + (lane & 31)]; }
    LDS_WAIT(); asm volatile("" ::: "memory");
    const int c = lane & 7;
#pragma unroll
    for (int j = 0; j < 4; ++j) { const int n = (lane >> 3) + 8 * j; const int cc = perm ? pg8::perm32(n) : n; const LAS float* s = scr + (8 * c) * 33 + cc;
        v4u o; o.x = pk2(s[0 * 33], s[1 * 33]); o.y = pk2(s[2 * 33], s[3 * 33]); o.z = pk2(s[4 * 33], s[5 * 33]); o.w = pk2(s[6 * 33], s[7 * 33]);
        *(GAS v4u*)(WT + (size_t)(32 * vb + n) * K + k0 + 8 * c) = o; }
    LDS_WAIT(); asm volatile("" ::: "memory");
}
__device__ __forceinline__ void rms_row_to_bf16(const float* xrow, const float* g, bf16_t* orow, int lane) {
    const GAS f32x4* xr = (const GAS f32x4*)xrow + lane;
    f32x4 v[4]; float s = 0.f;
#pragma unroll
    for (int j = 0; j < 4; ++j) { v[j] = xr[64 * j]; s += (v[j].x * v[j].x + v[j].y * v[j].y) + (v[j].z * v[j].z + v[j].w * v[j].w); }
    const float rstd = rsqrtf(wave_sum(s) * (1.f / DM) + EPS);
    GAS unsigned long long* o8 = (GAS unsigned long long*)orow + lane;
#pragma unroll
    for (int j = 0; j < 4; ++j) { const f32x4 gg = *((const GAS f32x4*)g + lane + 64 * j);
        o8[64 * j] = (unsigned long long)pk2(v[j].x * rstd * gg.x, v[j].y * rstd * gg.y) | ((unsigned long long)pk2(v[j].z * rstd * gg.z, v[j].w * rstd * gg.w) << 32); }
}
__device__ __forceinline__ void rms_row_to_f32(const float* xrow, const float* g, float* orow, int lane) {
    const GAS f32x4* xr = (const GAS f32x4*)xrow + lane;
    f32x4 v[4]; float s = 0.f;
#pragma unroll
    for (int j = 0; j < 4; ++j) { v[j] = xr[64 * j]; s += (v[j].x * v[j].x + v[j].y * v[j].y) + (v[j].z * v[j].z + v[j].w * v[j].w); }
    const float rstd = rsqrtf(wave_sum(s) * (1.f / DM) + EPS);
#pragma unroll
    for (int j = 0; j < 4; ++j) { const f32x4 gg = *((const GAS f32x4*)g + lane + 64 * j); *((GAS f32x4*)orow + lane + 64 * j) = v[j] * rstd * gg; }
}

constexpr int N_PHASES = 1 + 6 * DEPTH;
struct Args { const float* in[12]; float* out; unsigned char* ws; int ph_lo, ph_hi, li, pad; };
__global__ void __launch_bounds__(NWAVES * 64, 2) mega_fwd(Args args) {
    extern __shared__ __attribute__((aligned(16))) unsigned char lds[];
    LAS unsigned char* L = (LAS unsigned char*)lds;
    volatile LAS unsigned* MISC = (volatile LAS unsigned*)(L + MISC_OFF);
    const int tid = threadIdx.x, lane = tid & 63, wave = __builtin_amdgcn_readfirstlane(tid >> 6);
    const int G = gridDim.x; const int bx = blockIdx.x; const int vcu = (G % 8 == 0) ? (bx % 8) * (G / 8) + bx / 8 : bx;
    unsigned char* ws = args.ws; gu32* ctl = (gu32*)(ws + WS_CTL);
    const float* x = args.in[0]; const float* norm_g = args.in[1]; const float* w_in = args.in[2]; const float* qn = args.in[3]; const float* kn = args.in[4];
    const float* dec_f = args.in[5]; const float* dec_b = args.in[6]; const float* gnw = args.in[7]; const float* wba = args.in[8]; const float* wbr = args.in[9]; const float* wout = args.in[10]; const float* fng = args.in[11];
    float* out = args.out;
    bf16_t *XN = (bf16_t*)(ws + WS_XN), *QA = (bf16_t*)(ws + WS_QA), *KVA = (bf16_t*)(ws + WS_KVA), *GA = (bf16_t*)(ws + WS_GA), *QR = (bf16_t*)(ws + WS_QR), *KR = (bf16_t*)(ws + WS_KR),
           *VR = (bf16_t*)(ws + WS_VR), *GR = (bf16_t*)(ws + WS_GR), *GM = (bf16_t*)(ws + WS_GM), *MG = (bf16_t*)(ws + WS_MG);
    for (int u = tid; u < (LDS_BYTES - LDSCTL_OFF) / 4; u += NWAVES * 64) ((LAS unsigned*)(L + LDSCTL_OFF))[u] = 0u;
    { LAS float* tab = (LAS float*)(L + TAB_OFF);
      for (int i = tid; i < 2048; i += NWAVES * 64) {
          if (i < 1024) { const int p = i / 16, f = i % 16; const float a = (float)p * __builtin_amdgcn_exp2f(-(float)f * (13.287712379549449f / 16.f)); tab[i] = __cosf(a); tab[1024 + i] = __sinf(a); }
          { const int p = i / 32, f = i % 32; const float a = (float)p * __builtin_amdgcn_exp2f(-(float)f * (13.287712379549449f / 32.f)); tab[2048 + i] = __cosf(a); tab[4096 + i] = __sinf(a); } } }
    __syncthreads();
    XcdBarrier bar = xcd_barrier_post((unsigned*)(ctl + CW_BAR) + args.li * XCD_BAR_WORDS, MISC + 8);
    const int lo = args.ph_lo, hi = args.ph_hi;
#define IN(k) (lo <= (k) && (k) < hi)
#define SEAM(k) do { if (IN(k) && IN((k) + 1)) xcd_barrier(bar); } while (0)

    if (IN(0)) {
        LAS float* scr = (LAS float*)(L + RING_OFF + wave * 16384);
        const int gw = vcu * NWAVES + wave, NGW = G * NWAVES;
        constexpr int I_IN = (DM / 64) * (D_IN / 32), I_B = (512 / 64) * (DM / 32), I_O = (DM / 64) * (DM / 32);
        constexpr int NITEMS = DEPTH * (I_IN + 2 * I_B + I_O);
        for (int it = gw; it < NITEMS; it += NGW) {
            int r = it; const int l = r / (I_IN + 2 * I_B + I_O); r -= l * (I_IN + 2 * I_B + I_O);
            if (r < I_IN) { p0_transpose_item(w_in + (size_t)l * DM * D_IN, DM, D_IN, (bf16_t*)(ws + WS_WIN + l * WIN_L), scr, r, lane, 2); continue; } r -= I_IN;
            if (r < I_B) { p0_transpose_item(wba + (size_t)l * 512 * DM, 512, DM, (bf16_t*)(ws + WS_WB + l * WB_L), scr, r, lane, 1); continue; } r -= I_B;
            if (r < I_B) { p0_transpose_item(wbr + (size_t)l * 512 * DM, 512, DM, (bf16_t*)(ws + WS_WB + l * WB_L) + (size_t)1024 * 512, scr, r, lane, 1); continue; } r -= I_B;
            p0_transpose_item(wout + (size_t)l * DM * DM, DM, DM, (bf16_t*)(ws + WS_WOUT + l * WOUT_L), scr, r, lane, 0);
        }
        for (int m = gw; m < M; m += NGW) rms_row_to_bf16(x + (size_t)m * DM, norm_g, XN + (size_t)m * DM, lane);
    }
    SEAM(0);
    for (int l = 0; l < DEPTH; ++l) {
        const int pb = 1 + 6 * l;
        const float* xin = l == 0 ? x : out;
        if (IN(pb)) {
            pg8::Gemm g{XN, (const bf16_t*)(ws + WS_WIN + l * WIN_L), M, D_IN, DM}; pg8::StaticOrder S; S.init(M, D_IN, G, (int)blockIdx.x);
            pg8::EpiInProj E{QA, KVA, GA, QR, KR, VR, GR, GM, qn + l * 64, kn + l * 64, (const LAS float*)(L + TAB_OFF)};
            pg8::gemm_phase<pg8::EpiInProj, pg8::StaticOrder, true, true>(L + RING_OFF, g, S, E);
        }
        SEAM(pb);
        if (IN(pb + 1)) {
            for (int U = vcu; U < 256; U += G) {
                const int b = U >> 5, h = (U >> 3) & 3, dir = (U >> 2) & 1, e = U & 3;
                const float lg = -log2f(1.f + expf(-(dir ? dec_b : dec_f)[l * 4 + h]));
                ret_body::scan_unit(L + RING_OFF, b, h, dir, e, KR, VR, (bf16_t*)(ws + WS_ST), lg);
            }
        }
        SEAM(pb + 1);
        if (IN(pb + 2)) {
            const attn_body::AttnTensors AT{(const attn_body::bf16*)QA, (const attn_body::bf16*)KVA, (const attn_body::bf16*)GA, (attn_body::bf16*)QA};
            const attn_body::StaticOrder S((int)G, (int)blockIdx.x);
            attn_body::attn_phase<attn_body::StaticOrder>((char*)lds + RING_OFF, AT, S);
            for (int i = 0;; ++i) {
                int U; if (G == 256) { if (i >= 4) break; U = vcu * 4 + i; } else { U = i * G + vcu; if (U >= 1024) break; }
                const int b = U >> 7, h = (U >> 5) & 3, c = U & 31;
                const float lgf = -log2f(1.f + expf(-dec_f[l * 4 + h])), lgb = -log2f(1.f + expf(-dec_b[l * 4 + h]));
                ret_body::out_unit(L + RING_OFF, b, h, c, QR, KR, VR, GR, (const bf16_t*)(ws + WS_ST), gnw + l * 512, lgf, lgb);
            }
        }
        SEAM(pb + 2);
        if (IN(pb + 3)) {
            pg8::Gemm g{QA, (const bf16_t*)(ws + WS_WB + l * WB_L), M, DM, 512}; pg8::BranchOrder S{G, (int)blockIdx.x};
            pg8::EpiBranch E{GM, MG};
            pg8::gemm_phase<pg8::EpiBranch, pg8::BranchOrder, true, true>(L + RING_OFF, g, S, E);
        }
        SEAM(pb + 3);
        if (IN(pb + 4)) {
            pg8::Gemm g{MG, (const bf16_t*)(ws + WS_WOUT + l * WOUT_L), M, DM, DM}; pg8::StaticOrder S; S.init(M, DM, G, (int)blockIdx.x);
            pg8::EpiOut E{xin, out};
            pg8::gemm_phase<pg8::EpiOut, pg8::StaticOrder, true, true>(L + RING_OFF, g, S, E);
        }
        SEAM(pb + 4);
        if (IN(pb + 5)) {
            int ln = lane; asm volatile("" : "+v"(ln));
            const int gw = vcu * NWAVES + wave, NGW = G * NWAVES;
            if (l + 1 < DEPTH) { for (int m = gw; m < M; m += NGW) rms_row_to_bf16(out + (size_t)m * DM, norm_g + (l + 1) * DM, XN + (size_t)m * DM, ln); }
            else { for (int m = gw; m < M; m += NGW) rms_row_to_f32(out + (size_t)m * DM, fng, out + (size_t)m * DM, ln); }
        }
        if (l + 1 < DEPTH) SEAM(pb + 5);
    }
#undef IN
#undef SEAM
}

static void launch_phases(const Args& base, int lo, int hi, int li, int grid, hipStream_t stream) {
    Args a = base; a.ph_lo = lo; a.ph_hi = hi; a.li = li; a.pad = 0;
    hipLaunchKernelGGL(mega_fwd, dim3(grid), dim3(NWAVES * 64), LDS_BYTES, stream, a);
    const hipError_t le = hipPeekAtLastError();
    if (le != hipSuccess) fprintf(stderr, "kernel_launch: launch [%d,%d) failed: %s\n", lo, hi, hipGetErrorName(le));
}
extern "C" void kernel_launch(void* const* d_in, const int* in_sizes, int n_in, void* d_out, int out_size, void* d_ws, size_t ws_size, hipStream_t stream) {
    static int grid = 0;
    if (grid == 0) {
        if (n_in != 12 || out_size != M * DM || ws_size < WS_END) { fprintf(stderr, "kernel_launch: unexpected shapes n_in %d out %d ws %zu\n", n_in, out_size, ws_size); grid = -1; return; }
        int dev = 0, cus = 0, per_cu = 0;
        if (hipGetDevice(&dev) != hipSuccess || hipDeviceGetAttribute(&cus, hipDeviceAttributeMultiprocessorCount, dev) != hipSuccess) { grid = -1; return; }
        if (hipFuncSetAttribute((const void*)mega_fwd, hipFuncAttributeMaxDynamicSharedMemorySize, LDS_BYTES) != hipSuccess) { fprintf(stderr, "kernel_launch: hipFuncSetAttribute failed\n"); grid = -1; return; }
        if (hipOccupancyMaxActiveBlocksPerMultiprocessor(&per_cu, (const void*)mega_fwd, NWAVES * 64, LDS_BYTES) != hipSuccess || per_cu < 1) fprintf(stderr, "kernel_launch: occupancy query says %d\n", per_cu);
        (void)hipGetLastError();
        grid = cus;
    }
    if (grid < 0) return;
    if (hipMemsetAsync((char*)d_ws + WS_CTL, 0, CTL_ZERO_BYTES, stream) != hipSuccess) { fprintf(stderr, "kernel_launch: memset failed\n"); return; }
    Args a{};
    for (int i = 0; i < 12; ++i) a.in[i] = (const float*)d_in[i];
    a.out = (float*)d_out; a.ws = (unsigned char*)d_ws;
    unsigned char* ws = (unsigned char*)d_ws;
    bf16_t *QA = (bf16_t*)(ws + WS_QA), *KVA = (bf16_t*)(ws + WS_KVA), *GA = (bf16_t*)(ws + WS_GA), *QR = (bf16_t*)(ws + WS_QR), *KR = (bf16_t*)(ws + WS_KR), *VR = (bf16_t*)(ws + WS_VR), *GR = (bf16_t*)(ws + WS_GR);
    const float* dec_f = (const float*)d_in[5]; const float* dec_b = (const float*)d_in[6]; const float* gnw = (const float*)d_in[7];
    launch_phases(a, 0, N_PHASES, 0, grid, stream);
}
```
